# Optimizing an MI355X kernel written in HIP

```python
import jax, jax.numpy as jnp
from jax import lax
import numpy as np

D_MODEL = 1024
BATCH = 8
SEQ = 4096
DEPTH = 2

CHUNK = 64
N_A_LAYERS = DEPTH // 2
N_B_LAYERS = DEPTH - N_A_LAYERS
MIX_WIDTH = D_MODEL
MEM_TOKENS = 256
MEM_HEADS = 4
MEM_WIDTH = D_MODEL // 4
MEM_HEAD_DIM = MEM_WIDTH // MEM_HEADS
A_WIDTH = MIX_WIDTH - MEM_WIDTH
A_HEADS = 4
A_HEAD_DIM = A_WIDTH // A_HEADS
A_CONV = 4
B_HEAD_DIM = 64
B_HEADS = A_WIDTH // B_HEAD_DIM
B_WIDTH = B_HEADS * B_HEAD_DIM
BAND_CHUNKS = 9
BAND = BAND_CHUNKS * CHUNK
KV_PAD = BAND - CHUNK
MAX_REL = 128
REL_SIZE = MAX_REL + CHUNK
D_FF = ((8 * D_MODEL // 3 + 127) // 128) * 128
FFN_CONV = 3
A_IN = 4 * A_WIDTH + 2 * A_HEADS + MEM_WIDTH
B_IN = B_WIDTH + MEM_WIDTH
EPS = 1e-6

kernel_name = "yoco_mlstm_chunkband_memxattn_convffn"


def rmsnorm(x, g):
    x32 = x.astype(jnp.float32)
    y = x32 * lax.rsqrt(jnp.mean(x32 * x32, axis=-1, keepdims=True) + EPS)
    return (y * g.astype(jnp.float32)).astype(x.dtype)


def causal_dwconv(x, w, b):
    k = w.shape[0]
    s = x.shape[1]
    xp = jnp.pad(x, ((0, 0), (k - 1, 0), (0, 0)))
    y = xp[:, 0:s] * w[0]
    for j in range(1, k):
        y = y + xp[:, j:j + s] * w[j]
    return y + b


def mlstm_chunkwise(q, k, v, ig, logf):
    bsz, seq, nh, dh = q.shape
    nc = seq // CHUNK
    f32 = jnp.float32

    def to_chunks(t):
        t = t.astype(f32).reshape((bsz, nc, CHUNK) + t.shape[2:])
        perm = (1, 0, 3, 2) + tuple(range(4, t.ndim))
        return t.transpose(perm)

    qc, kc, vc = to_chunks(q), to_chunks(k * (dh ** -0.5)), to_chunks(v)
    igc, lfc = to_chunks(ig), to_chunks(logf)
    tril = jnp.tril(jnp.ones((CHUNK, CHUNK), dtype=bool))

    def step(carry, inp):
        c_st, n_st, m_st = carry
        qq, kk, vv, ii, lf = inp
        b = jnp.cumsum(lf, axis=-1)
        d = b[..., :, None] - b[..., None, :] + ii[..., None, :]
        d = jnp.where(tril, d, -jnp.inf)
        m_inter = b + m_st[..., None]
        m_t = jnp.maximum(m_inter, jnp.max(d, axis=-1))
        inter = jnp.exp(m_inter - m_t)
        s = jnp.einsum('bhtd,bhsd->bhts', qq, kk) * jnp.exp(d - m_t[..., None])
        num = jnp.einsum('bhts,bhse->bhte', s, vv) + inter[..., None] * jnp.einsum('bhtd,bhde->bhte', qq, c_st)
        den = jnp.sum(s, axis=-1) + inter * jnp.einsum('bhtd,bhd->bht', qq, n_st)
        h = num / jnp.maximum(jnp.abs(den), jnp.exp(-m_t))[..., None]
        b_last = b[..., -1]
        w = b_last[..., None] - b + ii
        m_new = jnp.maximum(b_last + m_st, jnp.max(w, axis=-1))
        w_exp = jnp.exp(w - m_new[..., None])
        decay = jnp.exp(b_last + m_st - m_new)
        c_new = decay[..., None, None] * c_st + jnp.einsum('bhs,bhsd,bhse->bhde', w_exp, kk, vv)
        n_new = decay[..., None] * n_st + jnp.einsum('bhs,bhsd->bhd', w_exp, kk)
        return (c_new, n_new, m_new), h

    init = (jnp.zeros((bsz, nh, dh, dh), f32), jnp.zeros((bsz, nh, dh), f32), jnp.zeros((bsz, nh), f32))
    _, h = lax.scan(step, init, (qc, kc, vc, igc, lfc))
    return h.transpose(1, 0, 3, 2, 4).reshape(bsz, seq, nh, dh)


def band_attention(q, k_pad, v_pad, rel_table):
    bsz, seq, _ = q.shape
    nc = seq // CHUNK
    q = q.reshape(bsz, seq, B_HEADS, B_HEAD_DIM)
    qi = jnp.arange(CHUNK)
    kj = jnp.arange(BAND)
    rel = KV_PAD + qi[:, None] - kj[None, :]
    idx = jnp.clip(rel, -(CHUNK - 1), MAX_REL) + (CHUNK - 1)
    bias = rel_table.astype(jnp.float32)[:, idx]
    scale = B_HEAD_DIM ** -0.5

    def one_chunk(c):
        start = c * CHUNK
        qc = lax.dynamic_slice_in_dim(q, start, CHUNK, axis=1)
        kc = lax.dynamic_slice_in_dim(k_pad, start, BAND, axis=1)
        vc = lax.dynamic_slice_in_dim(v_pad, start, BAND, axis=1)
        s = jnp.einsum('bqhd,bkhd->bhqk', qc, kc).astype(jnp.float32) * scale + bias
        valid = (start - KV_PAD + kj) >= 0
        s = jnp.where(valid, s, -jnp.inf)
        p = jax.nn.softmax(s, axis=-1).astype(vc.dtype)
        return jnp.einsum('bhqk,bkhd->bqhd', p, vc)

    out = lax.map(one_chunk, jnp.arange(nc))
    return out.transpose(1, 0, 2, 3, 4).reshape(bsz, seq, B_WIDTH)


def memory_attention(q, mem, w_kv):
    bsz, seq, _ = q.shape
    q = q.reshape(bsz, seq, MEM_HEADS, MEM_HEAD_DIM)
    mk, mv = jnp.split(mem @ w_kv, 2, axis=-1)
    mk = mk.reshape(bsz, -1, MEM_HEADS, MEM_HEAD_DIM)
    mv = mv.reshape(bsz, -1, MEM_HEADS, MEM_HEAD_DIM)
    s = jnp.einsum('bshd,bmhd->bhsm', q, mk).astype(jnp.float32) * (MEM_HEAD_DIM ** -0.5)
    p = jax.nn.softmax(s, axis=-1).astype(mv.dtype)
    return jnp.einsum('bhsm,bmhd->bshd', p, mv).reshape(bsz, seq, MEM_WIDTH)


def conv_ffn(h, w_up, conv_w, conv_b, w_down):
    u, g = jnp.split(h @ w_up, 2, axis=-1)
    g = causal_dwconv(g, conv_w, conv_b)
    return (jax.nn.silu(g) * u) @ w_down


def setup_inputs(seed: int = 0) -> dict:
    key = jax.random.key(seed)
    ks = jax.random.split(key, 24)
    f32 = jnp.float32

    def nrm(k, shape, scale):
        return jax.random.normal(k, shape, f32) * scale

    gate_b = jnp.concatenate([
        nrm(ks[5], (N_A_LAYERS, A_HEADS), 0.1),
        jnp.linspace(3.0, 6.0, A_HEADS, dtype=f32)[None, :] + nrm(ks[6], (N_A_LAYERS, A_HEADS), 0.1),
    ], axis=-1)
    return {
        "x": nrm(ks[0], (BATCH, SEQ, D_MODEL), 1.0),
        "mem": nrm(ks[1], (BATCH, MEM_TOKENS, D_MODEL), 1.0),
        "norm_mix_g": 1.0 + nrm(ks[2], (DEPTH, D_MODEL), 0.1),
        "norm_ffn_g": 1.0 + nrm(ks[3], (DEPTH, D_MODEL), 0.1),
        "a_w_in": nrm(ks[4], (N_A_LAYERS, D_MODEL, A_IN), D_MODEL ** -0.5),
        "a_gate_b": gate_b,
        "a_conv_w": nrm(ks[7], (N_A_LAYERS, A_CONV, 2 * A_WIDTH), A_CONV ** -0.5),
        "a_conv_b": nrm(ks[8], (N_A_LAYERS, 2 * A_WIDTH), 0.02),
        "a_head_g": 1.0 + nrm(ks[9], (N_A_LAYERS, A_WIDTH), 0.1),
        "a_w_out": nrm(ks[10], (N_A_LAYERS, MIX_WIDTH, D_MODEL), MIX_WIDTH ** -0.5),
        "kv_norm_g": 1.0 + nrm(ks[11], (D_MODEL,), 0.1),
        "w_kv": nrm(ks[12], (D_MODEL, 2 * B_WIDTH), D_MODEL ** -0.5),
        "b_w_in": nrm(ks[13], (N_B_LAYERS, D_MODEL, B_IN), D_MODEL ** -0.5),
        "b_rel_bias": nrm(ks[14], (N_B_LAYERS, B_HEADS, REL_SIZE), 0.5),
        "b_w_out": nrm(ks[15], (N_B_LAYERS, MIX_WIDTH, D_MODEL), MIX_WIDTH ** -0.5),
        "mem_w_kv": nrm(ks[16], (DEPTH, D_MODEL, 2 * MEM_WIDTH), D_MODEL ** -0.5),
        "ffn_w_up": nrm(ks[17], (DEPTH, D_MODEL, 2 * D_FF), D_MODEL ** -0.5),
        "ffn_conv_w": nrm(ks[18], (DEPTH, FFN_CONV, D_FF), FFN_CONV ** -0.5),
        "ffn_conv_b": nrm(ks[19], (DEPTH, D_FF), 0.02),
        "ffn_w_down": nrm(ks[20], (DEPTH, D_FF, D_MODEL), D_FF ** -0.5),
        "final_g": 1.0 + nrm(ks[21], (D_MODEL,), 0.1),
    }


def reference(x, mem, norm_mix_g, norm_ffn_g, a_w_in, a_gate_b, a_conv_w, a_conv_b, a_head_g, a_w_out,
              kv_norm_g, w_kv, b_w_in, b_rel_bias, b_w_out, mem_w_kv, ffn_w_up, ffn_conv_w, ffn_conv_b,
              ffn_w_down, final_g):
    bsz, seq, _ = x.shape
    k_pad = None
    v_pad = None
    for l in range(DEPTH):
        h = rmsnorm(x, norm_mix_g[l])
        if l < N_A_LAYERS:
            a = l
            proj = h @ a_w_in[a]
            qk, v, o, gates, q_mem = jnp.split(
                proj, [2 * A_WIDTH, 3 * A_WIDTH, 4 * A_WIDTH, 4 * A_WIDTH + 2 * A_HEADS], axis=-1)
            qk = jax.nn.silu(causal_dwconv(qk, a_conv_w[a], a_conv_b[a]))
            q, k = jnp.split(qk, 2, axis=-1)
            gates = gates.astype(jnp.float32) + a_gate_b[a].astype(jnp.float32)
            ig, fg = jnp.split(gates, 2, axis=-1)
            hm = mlstm_chunkwise(q.reshape(bsz, seq, A_HEADS, A_HEAD_DIM),
                                 k.reshape(bsz, seq, A_HEADS, A_HEAD_DIM),
                                 v.reshape(bsz, seq, A_HEADS, A_HEAD_DIM),
                                 ig, jax.nn.log_sigmoid(fg))
            hm = hm * lax.rsqrt(jnp.mean(hm * hm, axis=-1, keepdims=True) + EPS)
            hm = hm.reshape(bsz, seq, A_WIDTH) * a_head_g[a].astype(jnp.float32)
            mix_out = (hm * jax.nn.sigmoid(o.astype(jnp.float32))).astype(x.dtype)
            w_out = a_w_out[a]
        else:
            bl = l - N_A_LAYERS
            proj = h @ b_w_in[bl]
            q, q_mem = jnp.split(proj, [B_WIDTH], axis=-1)
            mix_out = band_attention(q, k_pad, v_pad, b_rel_bias[bl])
            w_out = b_w_out[bl]
        mem_out = memory_attention(q_mem, mem, mem_w_kv[l])
        x = x + jnp.concatenate([mix_out, mem_out], axis=-1) @ w_out
        x = x + conv_ffn(rmsnorm(x, norm_ffn_g[l]), ffn_w_up[l], ffn_conv_w[l], ffn_conv_b[l], ffn_w_down[l])
        if l == N_A_LAYERS - 1:
            ks_, vs_ = jnp.split(rmsnorm(x, kv_norm_g) @ w_kv, 2, axis=-1)
            pad = ((0, 0), (KV_PAD, 0), (0, 0), (0, 0))
            k_pad = jnp.pad(ks_.reshape(bsz, seq, B_HEADS, B_HEAD_DIM), pad)
            v_pad = jnp.pad(vs_.reshape(bsz, seq, B_HEADS, B_HEAD_DIM), pad)
    return rmsnorm(x, final_g)
```

```cpp
#include <hip/hip_runtime.h>
#include <hip/hip_cooperative_groups.h>
#include <cstdio>
#include <cstdint>
namespace cg = cooperative_groups;
namespace pg8 {
#define PG8_LAS __attribute__((address_space(3)))
typedef unsigned short bf16_t;
typedef short bf16x8 __attribute__((ext_vector_type(8)));
typedef float f32x4 __attribute__((ext_vector_type(4)));
typedef unsigned u32x4 __attribute__((ext_vector_type(4)));
constexpr int BM = 256, BK = 64, HALF = 128, HTB = HALF * BK * 2  , STAGE_BYTES = 8 * HTB, NXCD = 8, WGM = 8;

__host__ __device__ __forceinline__ int lds_byte(int r, int c) { const int st = (r >> 4) * 2 + (c >> 5), rr = r & 15, cc = c & 31, ob = rr * 64 + cc * 2; return st * 1024 + (ob ^ (((ob >> 9) & 1) << 5)); }
__host__ __device__ __forceinline__ void stage_rc(int b, int& R, int& C) { const int st = b / 1024, sb = b % 1024, swz = sb ^ (((sb >> 9) & 1) << 5); R = (st >> 1) * 16 + swz / 64; C = (st & 1) * 32 + (swz % 64) / 2; }
__host__ __device__ __forceinline__ int perm32(int rho) { const int n = rho >> 4, i = rho & 15; return 8 * (i >> 2) + 4 * n + (i & 3); }

struct Unit { int pm, pn; };
struct Gemm { const bf16_t* A; const bf16_t* Bt; int M, N, K, lda; };

struct StaticOrder {
    int nM, nN, nwg, G, c;
    __host__ __device__ void init(int M, int N, int G_, int c_) { nM = M / BM; nN = N / BM; nwg = nM * nN; G = G_; c = c_; }
    __host__ __device__ bool next(int i, Unit& u) const {
        const long L = (long)i * G + c; if (L >= nwg) return false;
        int wgid = (int)L; { const int q = nwg / NXCD, r = nwg % NXCD, xcd = wgid % NXCD, off = wgid / NXCD; wgid = (xcd < r ? xcd * (q + 1) : r * (q + 1) + (xcd - r) * q) + off; }
        const int nig = WGM * nN, gid = wgid / nig, fm = gid * WGM, gsz = (nM - fm) < WGM ? (nM - fm) : WGM;
        u.pm = fm + ((wgid % nig) % gsz); u.pn = (wgid % nig) / gsz; return true;
    }
    __device__ __forceinline__ void a_ready(const Unit&) const {}
    __device__ __forceinline__ void done(const Unit&) const {}
};

__device__ __forceinline__ unsigned cvt_pk_bf16(float lo, float hi) { unsigned r; asm volatile("v_cvt_pk_bf16_f32 %0, %1, %2" : "=v"(r) : "v"(lo), "v"(hi)); return r; }
typedef float f32x2 __attribute__((ext_vector_type(2)));
struct EpiBf16 {
    static constexpr bool PERM = true, AFTER_DRAIN = false;
    bf16_t* O; int ldc; int split_cols; size_t split_stride; const float* ssq;
    __device__ __forceinline__ void operator()(const f32x4 (&acc)[2][2][4][2], const Unit& u, int wr, int wc, int fr, int fq) const {
        const int row0 = u.pm * BM + wr * 64 + fr; int colt = u.pn * BM; bf16_t* base = O;
        if (split_cols) { const int t = colt / split_cols; base += (size_t)t * split_stride; colt -= t * split_cols; }
        const int col0 = colt + wc * 32 + 8 * fq;
        float rs[2][4];
#pragma unroll
        for (int ai = 0; ai < 2; ++ai)
#pragma unroll
            for (int m = 0; m < 4; ++m) { rs[ai][m] = 1.f;
                if (ssq) { const f32x4 a = *((const f32x4*)(ssq + (size_t)(row0 + ai * HALF + m * 16) * 16) + fq);
                    float t = (a[0] + a[1]) + (a[2] + a[3]); t += __shfl_xor(t, 16); t += __shfl_xor(t, 32);
                    rs[ai][m] = rsqrtf(t * (1.f / 1024.f) + 1e-6f); } }
#pragma unroll
        for (int ai = 0; ai < 2; ++ai)
#pragma unroll
            for (int m = 0; m < 4; ++m) { bf16_t* rowp = base + (size_t)(row0 + ai * HALF + m * 16) * ldc + col0; const float r_ = rs[ai][m];
#pragma unroll
                for (int bj = 0; bj < 2; ++bj) { const f32x4 v0 = acc[ai][bj][m][0] * r_, v1 = acc[ai][bj][m][1] * r_;
                    u32x4 w; w.x = cvt_pk_bf16(v0[0], v0[1]); w.y = cvt_pk_bf16(v0[2], v0[3]); w.z = cvt_pk_bf16(v1[0], v1[1]); w.w = cvt_pk_bf16(v1[2], v1[3]);
                    *(u32x4*)(rowp + bj * HALF) = w; } }
    }
};
__device__ __forceinline__ float dpp_ror1(float v) { return __int_as_float(__builtin_amdgcn_update_dpp(0, __float_as_int(v), 0x121, 0xf, 0xf, true)); }
__device__ __forceinline__ float dpp_ror2(float v) { return __int_as_float(__builtin_amdgcn_update_dpp(0, __float_as_int(v), 0x122, 0xf, 0xf, true)); }
struct EpiAct {
    static constexpr bool PERM = true, AFTER_DRAIN = false;
    bf16_t* ACT; bf16_t* SIDE; const float* ssq; const float* cw; const float* cb;
    __device__ __forceinline__ void operator()(const f32x4 (&acc)[2][2][4][2], const Unit& u, int wr, int wc, int fr, int fq) const {
        const int ch0 = u.pn * 128 + wc * 32 + 8 * fq;
        float rs[2][4];
#pragma unroll
        for (int ai = 0; ai < 2; ++ai)
#pragma unroll
            for (int m = 0; m < 4; ++m) { const f32x4 a = *((const f32x4*)(ssq + (size_t)(u.pm * BM + ai * HALF + wr * 64 + m * 16 + fr) * 16) + fq);
                float t = (a[0] + a[1]) + (a[2] + a[3]); t += __shfl_xor(t, 16); t += __shfl_xor(t, 32);
                rs[ai][m] = rsqrtf(t * (1.f / 1024.f) + 1e-6f); }
        typedef unsigned u32x2v __attribute__((ext_vector_type(2)));
        char* const actb = (char*)(ACT + (size_t)(u.pm * BM + wr * 64 + fr) * 2816 + ch0);
        char* const sideb = (char*)(SIDE + (size_t)(u.pm * 4 + wr) * (6 * 2816) + ch0);
        u32x2v keep[2][4];
#pragma unroll
        for (int n = 0; n < 2; ++n) {
            const int ch = ch0 + 4 * n;
            const f32x4 w0 = *(const f32x4*)(cw + ch) * -1.4426950408889634f, w1 = *(const f32x4*)(cw + 2816 + ch) * -1.4426950408889634f, w2 = *(const f32x4*)(cw + 5632 + ch) * -1.4426950408889634f,
                        bb = *(const f32x4*)(cb + ch) * -1.4426950408889634f;
#pragma unroll
            for (int ai = 0; ai < 2; ++ai) {
                f32x4 gp1 = {0.f, 0.f, 0.f, 0.f}, gp2 = {0.f, 0.f, 0.f, 0.f};
#pragma unroll
                for (int m = 0; m < 4; ++m) { const float r_ = rs[ai][m];
                    unsigned aoff = (unsigned)((ai * HALF + m * 16) * 2816 * 2 + n * 8), soff = (unsigned)(ai * 2 * 6 * 2816 * 2 + n * 8);
                    asm volatile("" : "+s"(aoff), "+s"(soff));
                    const f32x4 gc = acc[ai][1][m][n] * r_, uu = acc[ai][0][m][n] * (r_ * -0.6931471805599453f); f32x4 c1, c2, res;
#pragma unroll
                    for (int k = 0; k < 4; ++k) { c1[k] = dpp_ror1(gc[k]); c2[k] = dpp_ror2(gc[k]); }
#pragma unroll
                    for (int k = 0; k < 4; ++k) { const float p1 = fr >= 1 ? c1[k] : gp1[k], p2 = fr >= 2 ? c2[k] : gp2[k];
                        const float y = __builtin_fmaf(w0[k], p2, __builtin_fmaf(w1[k], p1, __builtin_fmaf(w2[k], gc[k], bb[k]))); res[k] = (y * uu[k]) * __builtin_amdgcn_rcpf(1.f + __builtin_amdgcn_exp2f(y)); }
                    gp1 = c1; gp2 = c2;
                    u32x2v w; w.x = cvt_pk_bf16(res[0], res[1]); w.y = cvt_pk_bf16(res[2], res[3]);
                    u32x2v wg; wg.x = cvt_pk_bf16(gc[0], gc[1]); wg.y = cvt_pk_bf16(gc[2], gc[3]);
                    char* const side = sideb + soff;
                    if (m == 0 && fr < 2) { const f32x4 up = acc[ai][0][m][n] * r_; u32x2v wu; wu.x = cvt_pk_bf16(up[0], up[1]); wu.y = cvt_pk_bf16(up[2], up[3]);
                        *(u32x2v*)(side + (2 + fr) * 5632) = wg; *(u32x2v*)(side + (4 + fr) * 5632) = wu; }
                    else if (n == 0) keep[ai][m] = w;
                    else { u32x4 w4; w4.x = keep[ai][m].x; w4.y = keep[ai][m].y; w4.z = w.x; w4.w = w.y; *(u32x4*)(actb + aoff - 8) = w4; }
                    if (m == 3 && fr >= 14) *(u32x2v*)(side + (fr - 14) * 5632) = wg;
                    __builtin_amdgcn_sched_barrier(0);
                }
            }
        }
    }
};
template <bool BASE32> struct EpiRes {
    static constexpr bool PERM = true, AFTER_DRAIN = false;
    const float* base32; bf16_t* xn; int ldc; float* ssq;
    __device__ __forceinline__ void operator()(const f32x4 (&acc)[2][2][4][2], const Unit& u, int wr, int wc, int fr, int fq) const {
        const int col0 = u.pn * BM + wc * 32 + 8 * fq;
#pragma unroll
        for (int ai = 0; ai < 2; ++ai)
#pragma unroll
            for (int m = 0; m < 4; ++m) { const int row = u.pm * BM + ai * HALF + wr * 64 + m * 16 + fr; const size_t off = (size_t)row * ldc + col0; float sq = 0.f;
#pragma unroll
                for (int bj = 0; bj < 2; ++bj) { const size_t p = off + bj * HALF; f32x4 b0, b1;
                    if (BASE32) { b0 = *(const f32x4*)(base32 + p); b1 = *(const f32x4*)(base32 + p + 4); }
                    else { const u32x4 r = *(const u32x4*)(xn + p);
                        b0 = (f32x4){__uint_as_float(r.x << 16), __uint_as_float(r.x & 0xffff0000u), __uint_as_float(r.y << 16), __uint_as_float(r.y & 0xffff0000u)};
                        b1 = (f32x4){__uint_as_float(r.z << 16), __uint_as_float(r.z & 0xffff0000u), __uint_as_float(r.w << 16), __uint_as_float(r.w & 0xffff0000u)}; }
                    const f32x4 o0 = b0 + acc[ai][bj][m][0], o1 = b1 + acc[ai][bj][m][1];
                    u32x4 w; w.x = cvt_pk_bf16(o0[0], o0[1]); w.y = cvt_pk_bf16(o0[2], o0[3]); w.z = cvt_pk_bf16(o1[0], o1[1]); w.w = cvt_pk_bf16(o1[2], o1[3]); *(u32x4*)(xn + p) = w;
                    const float q0 = __uint_as_float(w.x << 16), q1 = __uint_as_float(w.x & 0xffff0000u), q2 = __uint_as_float(w.y << 16), q3 = __uint_as_float(w.y & 0xffff0000u);
                    const float q4 = __uint_as_float(w.z << 16), q5 = __uint_as_float(w.z & 0xffff0000u), q6 = __uint_as_float(w.w << 16), q7 = __uint_as_float(w.w & 0xffff0000u);
                    sq += ((q0 * q0 + q1 * q1) + (q2 * q2 + q3 * q3)) + ((q4 * q4 + q5 * q5) + (q6 * q6 + q7 * q7)); }
                sq += __shfl_xor(sq, 16); sq += __shfl_xor(sq, 32);
                if (fq == 0) ssq[(size_t)row * 16 + u.pn * 4 + wc] = sq; }
    }
};
template <class Epi, class Sched, bool ALIGN_EPI = false, bool SP2 = false>
__device__ __forceinline__ void gemm_phase(PG8_LAS unsigned char* lds, const Gemm g, const Sched& S, const Epi& E) {
    int tid_ = threadIdx.x; asm volatile("" : "+v"(tid_));
    const int tid = tid_, wid = __builtin_amdgcn_readfirstlane(tid >> 6), lane = tid & 63, wr = wid >> 2, wc = wid & 3, fr = lane & 15, fq = lane >> 4;
    const int K = g.K, nt = K / BK;
    unsigned voffA[2], voffB[2];
#pragma unroll
    for (int i = 0; i < 2; ++i) { int R, C; stage_rc(tid * 16 + i * 8192, R, C); const int Rb = Epi::PERM ? ((R & ~31) + perm32(R & 31)) : R;
        voffA[i] = (unsigned)(R * g.lda + C) * 2u; voffB[i] = (unsigned)(Rb * K + C) * 2u; }
    const size_t kstep = (size_t)(BK * 2);
    const size_t hstep = (size_t)HALF * K * 2;
    const size_t tstep = 2 * hstep;
    const size_t hstepA = (size_t)HALF * g.lda * 2, tstepA = 2 * hstepA;
    const unsigned ldsw = (unsigned)wid * 1024u;
    const int aoff = lds_byte(wr * 64 + fr, fq * 8), boff = lds_byte(wc * 32 + fr, fq * 8);
#define PG8_SA(b, h) (((b) * 2 + (h)) * HTB)
#define PG8_SB(b, h) ((4 + (b) * 2 + (h)) * HTB)
#define PG8_STAGE(bufoff, gbase, voff) do { _Pragma("unroll") for (int _i = 0; _i < 2; ++_i) \
        __builtin_amdgcn_global_load_lds((const unsigned*)((const char*)(gbase) + (voff)[_i]), (PG8_LAS unsigned*)(lds + (bufoff) + ldsw + _i * 8192), 16, 0, 0); } while (0)
#define PG8_LDA(dst, b, h) do { _Pragma("unroll") for (int m = 0; m < 4; ++m) _Pragma("unroll") for (int k = 0; k < 2; ++k) dst[m][k] = *(const PG8_LAS bf16x8*)(lds + PG8_SA(b, h) + aoff + m * 2048 + k * 1024); } while (0)
#define PG8_LDB(dst, b, h) do { _Pragma("unroll") for (int n = 0; n < 2; ++n) _Pragma("unroll") for (int k = 0; k < 2; ++k) dst[n][k] = *(const PG8_LAS bf16x8*)(lds + PG8_SB(b, h) + boff + n * 2048 + k * 1024); } while (0)
#define PG8_MMA(ai, bj, At, Bt) do { __builtin_amdgcn_s_setprio(1); _Pragma("unroll") for (int m = 0; m < 4; ++m) _Pragma("unroll") for (int n = 0; n < 2; ++n) _Pragma("unroll") for (int k = 0; k < 2; ++k) \
        acc[ai][bj][m][n] = __builtin_amdgcn_mfma_f32_16x16x32_bf16(Bt[n][k], At[m][k], acc[ai][bj][m][n], 0, 0, 0); __builtin_amdgcn_s_setprio(0); } while (0)
#define PG8_WAIT_V(n) asm volatile("s_waitcnt vmcnt(" #n ")" ::: "memory")
#define PG8_WAIT_L(n) asm volatile("s_waitcnt lgkmcnt(" #n ")" ::: "memory")
#define PG8_BAR __builtin_amdgcn_s_barrier()
#define PG8_SCHED __builtin_amdgcn_sched_barrier(0)
    Unit cur, nxt; int ui = 0;
    if (!S.next(0, cur)) return;
    f32x4 acc[2][2][4][2];
#pragma unroll
    for (int a = 0; a < 2; ++a)
#pragma unroll
        for (int b = 0; b < 2; ++b)
#pragma unroll
            for (int m = 0; m < 4; ++m)
#pragma unroll
                for (int n = 0; n < 2; ++n) acc[a][b][m][n] = (f32x4){0.f, 0.f, 0.f, 0.f};
    bf16x8 At[4][2], B0[2][2], B1[2][2];
    const char* cA = (const char*)g.A + (size_t)cur.pm * tstepA; const char* cB = (const char*)g.Bt + (size_t)cur.pn * tstep;
    S.a_ready(cur);
    if constexpr (SP2) {
        PG8_STAGE(PG8_SB(0, 0), cB, voffB); PG8_STAGE(PG8_SB(0, 1), cB + hstep, voffB); PG8_STAGE(PG8_SA(0, 0), cA, voffA); PG8_STAGE(PG8_SA(0, 1), cA + hstepA, voffA);
        if (wr == 1) PG8_BAR;
        PG8_WAIT_V(2); PG8_BAR;
        PG8_STAGE(PG8_SB(1, 0), cB + kstep, voffB); PG8_STAGE(PG8_SA(1, 0), cA + kstep, voffA); PG8_STAGE(PG8_SB(1, 1), cB + hstep + kstep, voffB);
        PG8_WAIT_V(6); PG8_BAR;
    } else {
        PG8_STAGE(PG8_SB(0, 0), cB, voffB); PG8_STAGE(PG8_SA(0, 0), cA, voffA); PG8_STAGE(PG8_SB(0, 1), cB + hstep, voffB); PG8_STAGE(PG8_SA(0, 1), cA + hstepA, voffA);
        if (wr == 1) PG8_BAR;
        PG8_WAIT_V(4); PG8_BAR;
        PG8_STAGE(PG8_SB(1, 0), cB + kstep, voffB); PG8_STAGE(PG8_SA(1, 0), cA + kstep, voffA); PG8_STAGE(PG8_SB(1, 1), cB + hstep + kstep, voffB);
        PG8_WAIT_V(6); PG8_BAR;
    }
    for (;;) {
        const bool has_next = S.next(ui + 1, nxt);
        const char* nA = has_next ? (const char*)g.A + (size_t)nxt.pm * tstepA : cA; const char* nB = has_next ? (const char*)g.Bt + (size_t)nxt.pn * tstep : cB;
        for (int t = 0; t < nt; t += 2) {
            const bool last = (t == nt - 2);
            const char* a1 = cA + (size_t)(t + 1) * kstep;
            const char* a2 = last ? nA : cA + (size_t)(t + 2) * kstep; const char* b2 = last ? nB : cB + (size_t)(t + 2) * kstep;
            const char* a3 = a2 + kstep; const char* b3 = b2 + kstep;
            if (last && has_next) S.a_ready(nxt);
            if constexpr (SP2) {
            PG8_LDB(B0, 0, 0); PG8_LDB(B1, 0, 1); PG8_SCHED; PG8_LDA(At, 0, 0); PG8_STAGE(PG8_SA(1, 1), a1 + hstepA, voffA);
            PG8_WAIT_V(8); PG8_WAIT_L(0); PG8_BAR; PG8_MMA(0, 0, At, B0); PG8_MMA(0, 1, At, B1); PG8_BAR; PG8_SCHED;
            PG8_LDA(At, 0, 1); PG8_STAGE(PG8_SB(0, 0), b2, voffB); PG8_STAGE(PG8_SB(0, 1), b2 + hstep, voffB); PG8_STAGE(PG8_SA(0, 0), a2, voffA);
            PG8_WAIT_V(8); PG8_WAIT_L(0); PG8_BAR; PG8_MMA(1, 0, At, B0); PG8_MMA(1, 1, At, B1); PG8_BAR; PG8_SCHED;
            PG8_LDB(B0, 1, 0); PG8_LDB(B1, 1, 1); PG8_SCHED; PG8_LDA(At, 1, 0); PG8_STAGE(PG8_SA(0, 1), a2 + hstepA, voffA);
            PG8_WAIT_V(8); PG8_WAIT_L(0); PG8_BAR; PG8_MMA(0, 0, At, B0); PG8_MMA(0, 1, At, B1); PG8_BAR; PG8_SCHED;
            PG8_LDA(At, 1, 1); PG8_STAGE(PG8_SB(1, 0), b3, voffB); PG8_STAGE(PG8_SB(1, 1), b3 + hstep, voffB); PG8_STAGE(PG8_SA(1, 0), a3, voffA);
            PG8_WAIT_V(8); PG8_WAIT_L(0); PG8_BAR; PG8_MMA(1, 0, At, B0); PG8_MMA(1, 1, At, B1); PG8_BAR; PG8_SCHED;
            } else {
            PG8_LDB(B0, 0, 0); PG8_SCHED; PG8_LDA(At, 0, 0); PG8_STAGE(PG8_SA(1, 1), a1 + hstepA, voffA);
            PG8_WAIT_L(8); PG8_BAR; PG8_WAIT_L(0); PG8_MMA(0, 0, At, B0); PG8_BAR; PG8_SCHED;
            PG8_LDB(B1, 0, 1); PG8_STAGE(PG8_SB(0, 0), b2, voffB);
            PG8_BAR; PG8_WAIT_L(0); PG8_MMA(0, 1, At, B1); PG8_BAR;
            PG8_LDA(At, 0, 1); PG8_STAGE(PG8_SA(0, 0), a2, voffA);
            PG8_BAR; PG8_WAIT_L(0); PG8_MMA(1, 0, At, B0); PG8_BAR; PG8_SCHED;
            PG8_STAGE(PG8_SB(0, 1), b2 + hstep, voffB);
            PG8_WAIT_V(6); PG8_BAR; PG8_MMA(1, 1, At, B1); PG8_BAR;
            PG8_LDB(B0, 1, 0); PG8_SCHED; PG8_LDA(At, 1, 0); PG8_STAGE(PG8_SA(0, 1), a2 + hstepA, voffA);
            PG8_WAIT_L(8); PG8_BAR; PG8_WAIT_L(0); PG8_MMA(0, 0, At, B0); PG8_BAR; PG8_SCHED;
            PG8_LDB(B1, 1, 1); PG8_STAGE(PG8_SB(1, 0), b3, voffB);
            PG8_BAR; PG8_WAIT_L(0); PG8_MMA(0, 1, At, B1); PG8_BAR;
            PG8_LDA(At, 1, 1); PG8_STAGE(PG8_SA(1, 0), a3, voffA);
            PG8_BAR; PG8_WAIT_L(0); PG8_MMA(1, 0, At, B0); PG8_BAR; PG8_SCHED;
            PG8_STAGE(PG8_SB(1, 1), b3 + hstep, voffB);
            PG8_WAIT_V(6); PG8_BAR; PG8_MMA(1, 1, At, B1); PG8_BAR;
            }
        }
        if constexpr (ALIGN_EPI) { if (wr == 0) PG8_BAR; }
        if constexpr (!Epi::AFTER_DRAIN) { E(acc, cur, wr, wc, fr, fq); S.done(cur); }
        if (!has_next) break;
#pragma unroll
        for (int a = 0; a < 2; ++a)
#pragma unroll
            for (int b = 0; b < 2; ++b)
#pragma unroll
                for (int m = 0; m < 4; ++m)
#pragma unroll
                    for (int n = 0; n < 2; ++n) acc[a][b][m][n] = (f32x4){0.f, 0.f, 0.f, 0.f};
        cur = nxt; cA = nA; cB = nB; ++ui;
        if constexpr (ALIGN_EPI) { if (wr == 1) PG8_BAR; }
    }
    PG8_WAIT_V(0);
    if constexpr (!ALIGN_EPI) { if (wr == 0) PG8_BAR; }
    PG8_BAR;
    if constexpr (Epi::AFTER_DRAIN) { E.fused(acc, cur, wr, wc, fr, fq, lds, wid, lane); S.done(cur); }
#undef PG8_SA
#undef PG8_SB
#undef PG8_STAGE
#undef PG8_LDA
#undef PG8_LDB
#undef PG8_MMA
#undef PG8_WAIT_V
#undef PG8_WAIT_L
#undef PG8_BAR
#undef PG8_SCHED
}
}

typedef unsigned short bf16;
typedef short bf16x8 __attribute__((ext_vector_type(8)));
typedef float f32x4 __attribute__((ext_vector_type(4)));
typedef unsigned u32x4 __attribute__((ext_vector_type(4)));
typedef unsigned u32x2 __attribute__((ext_vector_type(2)));
#define LAS __attribute__((address_space(3)))

constexpr int NB = 8, SEQ = 4096, DM = 1024, MTOK = NB * SEQ;
constexpr int NPA = 3584, NPB = 2560, DFF = 2816;
constexpr int PA_K = 768, PA_V = 1536, PA_O = 2304, PA_QM = 3072, PA_G = 3328;
constexpr int PB_QM = 768, PB_K = 1024, PB_V = 1792;
constexpr size_t MiB = 1u << 20;
constexpr size_t WS_WAIN = 1 * MiB, WS_WAOUT = 8 * MiB, WS_WB = 10 * MiB, WS_WBOUT = 15 * MiB, WS_WM = 17 * MiB, WS_WUP0 = 19 * MiB, WS_WUP1 = 30 * MiB,
                 WS_WDN0 = 41 * MiB, WS_WDN1 = 47 * MiB, WS_MEMB = 53 * MiB, WS_MKV = 57 * MiB, WS_DN = 61 * MiB, WS_SC = 63 * MiB, WS_XN = 64 * MiB, WS_BIG = 128 * MiB;
constexpr size_t WS_GATES = 498 * MiB;
constexpr size_t WS_SSQ = 496 * MiB, WS_MIXB = WS_BIG + 160 * MiB;
constexpr size_t WS_PA = WS_BIG, WS_CS = WS_BIG + 224 * MiB, WS_U = WS_BIG, WS_G = WS_BIG + 176 * MiB, WS_PB = WS_BIG, WS_END = 499 * MiB;
constexpr int LDS_BYTES = 147456;
constexpr int NPHASE = 19;
#ifndef MK_REP
#define MK_REP -1
#define MK_NREP 1
#endif
#ifndef MK_SP2
#define MK_SP2 true
#endif

__device__ __forceinline__ float bf2f(bf16 h) { return __uint_as_float((unsigned)h << 16); }
typedef float f32x2_t __attribute__((ext_vector_type(2)));
typedef __bf16 bf16x2_t __attribute__((ext_vector_type(2)));
__device__ __forceinline__ unsigned pk2(float lo, float hi) { const f32x2_t v = {lo, hi}; const bf16x2_t b = __builtin_convertvector(v, bf16x2_t); return __builtin_bit_cast(unsigned, b); }
__device__ __forceinline__ bf16 f2bf(float f) { return (bf16)(pk2(f, f) & 0xffffu); }
__device__ __forceinline__ void unpack8(const u32x4 w, float* f) {
    f[0] = __uint_as_float(w.x << 16); f[1] = __uint_as_float(w.x & 0xffff0000u); f[2] = __uint_as_float(w.y << 16); f[3] = __uint_as_float(w.y & 0xffff0000u);
    f[4] = __uint_as_float(w.z << 16); f[5] = __uint_as_float(w.z & 0xffff0000u); f[6] = __uint_as_float(w.w << 16); f[7] = __uint_as_float(w.w & 0xffff0000u); }
__device__ __forceinline__ u32x4 pack8(const float* f) { u32x4 o; o.x = pk2(f[0], f[1]); o.y = pk2(f[2], f[3]); o.z = pk2(f[4], f[5]); o.w = pk2(f[6], f[7]); return o; }
__device__ __forceinline__ float wave_sum(float v) {
#pragma unroll
    for (int o = 1; o < 64; o <<= 1) v += __shfl_xor(v, o);
    return v; }
__device__ __forceinline__ float wave_max(float v) {
#pragma unroll
    for (int o = 1; o < 64; o <<= 1) v = fmaxf(v, __shfl_xor(v, o));
    return v; }
__device__ __forceinline__ float wave_incl_sum(float x, int lane) {
#pragma unroll
    for (int o = 1; o < 64; o <<= 1) { const float v = __shfl_up(x, o); if (lane >= o) x += v; }
    return x; }
__device__ __forceinline__ float wave_incl_max(float x, int lane) {
#pragma unroll
    for (int o = 1; o < 64; o <<= 1) { const float v = __shfl_up(x, o); if (lane >= o) x = fmaxf(x, v); }
    return x; }
__device__ __forceinline__ float logsigmoidf_(float x) { return fminf(x, 0.f) - log1pf(__expf(-fabsf(x))); }
__device__ __forceinline__ float siluf_(float x) { return x * __builtin_amdgcn_rcpf(1.f + __expf(-x)); }
#define MFMA16(a, b, c) __builtin_amdgcn_mfma_f32_16x16x32_bf16((a), (b), (c), 0, 0, 0)
#define LDSW() asm volatile("s_waitcnt lgkmcnt(0)" ::: "memory")

__device__ __forceinline__ int src_col_ain(int nd) { return nd < 3072 ? nd : nd + 8; }
__device__ __forceinline__ void tr_item(const float* __restrict__ W, int K, int ldw, const float* __restrict__ gain, bf16* WT, int mode, int item, int nblk, float* scr, int lane) {
    const int kb = item / nblk, nb = item % nblk, k0 = 64 * kb, nd0 = 32 * nb;
    const int krow = lane >> 3, c4 = lane & 7, nd = nd0 + 4 * c4;
    const int sc = mode == 1 ? src_col_ain(nd) : (mode == 2 ? ((nd >> 7) & 1) * 2816 + (nd >> 8) * 128 + (nd & 127) : nd);
#pragma unroll
    for (int i = 0; i < 8; ++i) { const int kk = 8 * i + krow; f32x4 v = {0.f, 0.f, 0.f, 0.f};
        if (sc >= 0) { v = *(const f32x4*)&W[(size_t)(k0 + kk) * ldw + sc]; if (gain) v = v * gain[k0 + kk]; }
        float* d = scr + kk * 33 + 4 * c4; d[0] = v.x; d[1] = v.y; d[2] = v.z; d[3] = v.w; }
    LDSW();
    const int c = lane & 7;
#pragma unroll
    for (int j = 0; j < 4; ++j) { const int n = (lane >> 3) + 8 * j; const float* s = scr + (8 * c) * 33 + n;
        u32x4 o; o.x = pk2(s[0], s[33]); o.y = pk2(s[66], s[99]); o.z = pk2(s[132], s[165]); o.w = pk2(s[198], s[231]);
        *(u32x4*)(WT + (size_t)(nd0 + n) * K + k0 + 8 * c) = o; }
    LDSW();
}
template <bool NORM> __device__ __forceinline__ void row_to_bf16(const float* xrow, bf16* orow, int lane) {
    const f32x4* xr = (const f32x4*)xrow + lane; f32x4 v[4]; float s = 0.f;
#pragma unroll
    for (int j = 0; j < 4; ++j) { v[j] = xr[64 * j]; s += (v[j].x * v[j].x + v[j].y * v[j].y) + (v[j].z * v[j].z + v[j].w * v[j].w); }
    float rs = 1.f;
    if (NORM) rs = rsqrtf(wave_sum(s) * (1.f / 1024.f) + 1e-6f);
    u32x2* o = (u32x2*)orow + lane;
#pragma unroll
    for (int j = 0; j < 4; ++j) { u32x2 t; t.x = pk2(v[j].x * rs, v[j].y * rs); t.y = pk2(v[j].z * rs, v[j].w * rs); o[64 * j] = t; }
}
__device__ __forceinline__ void row2_to_bf16(const float* xrow, bf16* orow, int lane) {
    const f32x4* xr = (const f32x4*)xrow + lane; f32x4 v[2][4]; float s0 = 0.f, s1 = 0.f;
#pragma unroll
    for (int j = 0; j < 4; ++j) { v[0][j] = xr[64 * j]; v[1][j] = xr[256 + 64 * j]; }
#pragma unroll
    for (int j = 0; j < 4; ++j) { s0 += (v[0][j].x * v[0][j].x + v[0][j].y * v[0][j].y) + (v[0][j].z * v[0][j].z + v[0][j].w * v[0][j].w);
        s1 += (v[1][j].x * v[1][j].x + v[1][j].y * v[1][j].y) + (v[1][j].z * v[1][j].z + v[1][j].w * v[1][j].w); }
#pragma unroll
    for (int o = 1; o < 64; o <<= 1) { s0 += __shfl_xor(s0, o); s1 += __shfl_xor(s1, o); }
    const float r0 = rsqrtf(s0 * (1.f / 1024.f) + 1e-6f), r1 = rsqrtf(s1 * (1.f / 1024.f) + 1e-6f);
    u32x2* o = (u32x2*)orow + lane;
#pragma unroll
    for (int j = 0; j < 4; ++j) { u32x2 t; t.x = pk2(v[0][j].x * r0, v[0][j].y * r0); t.y = pk2(v[0][j].z * r0, v[0][j].w * r0); o[64 * j] = t;
        u32x2 t1; t1.x = pk2(v[1][j].x * r1, v[1][j].y * r1); t1.y = pk2(v[1][j].z * r1, v[1][j].w * r1); o[256 + 64 * j] = t1; }
}
__device__ __forceinline__ void row2_gates(const float* xrow, bf16* orow, float* grow, const float* wg, int lane) {
    f32x4 v[2][4]; float s0 = 0.f, s1 = 0.f;
#pragma unroll
    for (int j = 0; j < 2; ++j) { const f32x4* p0 = (const f32x4*)(xrow + 8 * lane + 512 * j); const f32x4* p1 = (const f32x4*)(xrow + 1024 + 8 * lane + 512 * j);
        v[0][2 * j] = p0[0]; v[0][2 * j + 1] = p0[1]; v[1][2 * j] = p1[0]; v[1][2 * j + 1] = p1[1]; }
#pragma unroll
    for (int j = 0; j < 4; ++j) { s0 += (v[0][j].x * v[0][j].x + v[0][j].y * v[0][j].y) + (v[0][j].z * v[0][j].z + v[0][j].w * v[0][j].w);
        s1 += (v[1][j].x * v[1][j].x + v[1][j].y * v[1][j].y) + (v[1][j].z * v[1][j].z + v[1][j].w * v[1][j].w); }
    float g0[8], g1[8];
#pragma unroll
    for (int c = 0; c < 8; ++c) { float a0 = 0.f, a1 = 0.f;
#pragma unroll
        for (int j = 0; j < 4; ++j) { const f32x4 w = *(const f32x4*)(wg + c * 1024 + 8 * lane + 512 * (j >> 1) + 4 * (j & 1));
            a0 += (v[0][j].x * w.x + v[0][j].y * w.y) + (v[0][j].z * w.z + v[0][j].w * w.w); a1 += (v[1][j].x * w.x + v[1][j].y * w.y) + (v[1][j].z * w.z + v[1][j].w * w.w); }
        g0[c] = a0; g1[c] = a1; }
#pragma unroll
    for (int o = 1; o < 64; o <<= 1) { s0 += __shfl_xor(s0, o); s1 += __shfl_xor(s1, o); }
    float gv[16];
#pragma unroll
    for (int c = 0; c < 8; ++c) { gv[c] = g0[c]; gv[8 + c] = g1[c]; }
    { const bool hb = (lane & 32) != 0;
#pragma unroll
      for (int i = 0; i < 8; ++i) { const float send = hb ? gv[i] : gv[i + 8], keep = hb ? gv[i + 8] : gv[i]; gv[i] = keep + __shfl_xor(send, 32); } }
    { const bool hb = (lane & 16) != 0;
#pragma unroll
      for (int i = 0; i < 4; ++i) { const float send = hb ? gv[i] : gv[i + 4], keep = hb ? gv[i + 4] : gv[i]; gv[i] = keep + __shfl_xor(send, 16); } }
    { const bool hb = (lane & 8) != 0;
#pragma unroll
      for (int i = 0; i < 2; ++i) { const float send = hb ? gv[i] : gv[i + 2], keep = hb ? gv[i + 2] : gv[i]; gv[i] = keep + __shfl_xor(send, 8); } }
    { const bool hb = (lane & 4) != 0; const float send = hb ? gv[0] : gv[1], keep = hb ? gv[1] : gv[0]; gv[0] = keep + __shfl_xor(send, 4); }
    gv[0] += __shfl_xor(gv[0], 2); gv[0] += __shfl_xor(gv[0], 1);
    const float r0 = rsqrtf(s0 * (1.f / 1024.f) + 1e-6f), r1 = rsqrtf(s1 * (1.f / 1024.f) + 1e-6f);
#pragma unroll
    for (int j = 0; j < 2; ++j) { u32x4 t0, t1;
        t0.x = pk2(v[0][2 * j].x * r0, v[0][2 * j].y * r0); t0.y = pk2(v[0][2 * j].z * r0, v[0][2 * j].w * r0); t0.z = pk2(v[0][2 * j + 1].x * r0, v[0][2 * j + 1].y * r0); t0.w = pk2(v[0][2 * j + 1].z * r0, v[0][2 * j + 1].w * r0);
        t1.x = pk2(v[1][2 * j].x * r1, v[1][2 * j].y * r1); t1.y = pk2(v[1][2 * j].z * r1, v[1][2 * j].w * r1); t1.z = pk2(v[1][2 * j + 1].x * r1, v[1][2 * j + 1].y * r1); t1.w = pk2(v[1][2 * j + 1].z * r1, v[1][2 * j + 1].w * r1);
        *(u32x4*)(orow + 8 * lane + 512 * j) = t0; *(u32x4*)(orow + 1024 + 8 * lane + 512 * j) = t1; }
    if ((lane & 3) == 0) grow[lane >> 2] = gv[0] * ((lane & 32) ? r1 : r0);
}
__device__ __forceinline__ void final_norm_row(const bf16* xrow, const float* ssq16, float* orow, const float* g, int lane) {
    const f32x4* sp = (const f32x4*)ssq16; const f32x4 a = sp[0], b = sp[1], c = sp[2], d = sp[3];
    const float t = ((a[0] + a[1]) + (a[2] + a[3])) + ((b[0] + b[1]) + (b[2] + b[3])) + ((c[0] + c[1]) + (c[2] + c[3])) + ((d[0] + d[1]) + (d[2] + d[3]));
    const float rs = rsqrtf(t * (1.f / 1024.f) + 1e-6f);
#pragma unroll
    for (int j = 0; j < 2; ++j) { const u32x4 r = *((const u32x4*)xrow + lane + 64 * j); float f[8]; unpack8(r, f);
        const f32x4 g0 = *((const f32x4*)g + 2 * (lane + 64 * j)), g1 = *((const f32x4*)g + 2 * (lane + 64 * j) + 1);
        f32x4 o0 = {f[0] * rs * g0.x, f[1] * rs * g0.y, f[2] * rs * g0.z, f[3] * rs * g0.w}, o1 = {f[4] * rs * g1.x, f[5] * rs * g1.y, f[6] * rs * g1.z, f[7] * rs * g1.w};
        *((f32x4*)orow + 2 * (lane + 64 * j)) = o0; *((f32x4*)orow + 2 * (lane + 64 * j) + 1) = o1; }
}

__device__ __forceinline__ void attn_item(char* lds, int tid, const bf16* Qp, int ldq, const bf16* Kb, const bf16* Vb, long krow0, int ldkv, int nkc, int jfirst,
                                          const float* relg, bf16* Op, int ldo) {
    const int hf = tid >> 8, th = tid & 255, w = th >> 6, lane = tid & 63, r = lane & 15, q = lane >> 4;
    char* base = lds + hf * 40960;
    bf16* Qs = (bf16*)base; bf16* Ks = Qs + 4608; bf16* Vt = Ks + 4608; bf16* Ps = Vt + 4608 + w * 1152; float* rel = (float*)(base + 36864);
    __syncthreads();
#pragma unroll
    for (int i = 0; i < 2; ++i) { const int idx = th + 256 * i, row = idx >> 3, cv = idx & 7; *(u32x4*)&Qs[row * 72 + 8 * cv] = *(const u32x4*)&Qp[(size_t)row * ldq + 8 * cv]; }
    const bool has_rel = relg != nullptr;
    if (has_rel && th < 192) rel[th] = relg[th];
    f32x4 o[4]; float mrun[4], lrun[4];
#pragma unroll
    for (int i = 0; i < 4; ++i) { o[i] = (f32x4){0.f, 0.f, 0.f, 0.f}; mrun[i] = -1e30f; lrun[i] = 0.f; }
    for (int j = jfirst; j < nkc; ++j) {
        __syncthreads();
        const bf16* Kj = Kb + (krow0 + 64 * j) * (long)ldkv; const bf16* Vj = Vb + (krow0 + 64 * j) * (long)ldkv;
#pragma unroll
        for (int i = 0; i < 2; ++i) { const int idx = th + 256 * i, row = idx >> 3, cv = idx & 7; *(u32x4*)&Ks[row * 72 + 8 * cv] = *(const u32x4*)&Kj[(size_t)row * ldkv + 8 * cv]; }
#pragma unroll
        for (int i = 0; i < 2; ++i) { const int idx = th + 256 * i, s_ = idx & 63, cv = idx >> 6; const u32x4 v = *(const u32x4*)&Vj[(size_t)s_ * ldkv + 8 * cv];
            bf16* d = Vt + (8 * cv) * 72 + s_;
            d[0] = (bf16)(v.x & 0xffffu); d[72] = (bf16)(v.x >> 16); d[144] = (bf16)(v.y & 0xffffu); d[216] = (bf16)(v.y >> 16);
            d[288] = (bf16)(v.z & 0xffffu); d[360] = (bf16)(v.z >> 16); d[432] = (bf16)(v.w & 0xffffu); d[504] = (bf16)(v.w >> 16); }
        __syncthreads();
        bf16x8 aq[2];
#pragma unroll
        for (int ks = 0; ks < 2; ++ks) aq[ks] = *(const bf16x8*)&Qs[(16 * w + r) * 72 + 32 * ks + 8 * q];
        f32x4 s[4];
#pragma unroll
        for (int nt = 0; nt < 4; ++nt) { s[nt] = (f32x4){0.f, 0.f, 0.f, 0.f};
#pragma unroll
            for (int ks = 0; ks < 2; ++ks) { const bf16x8 bk = *(const bf16x8*)&Ks[(16 * nt + r) * 72 + 32 * ks + 8 * q]; s[nt] = MFMA16(aq[ks], bk, s[nt]); } }
#pragma unroll
        for (int jj = 0; jj < 4; ++jj) {
            float mx = -1e30f;
#pragma unroll
            for (int nt = 0; nt < 4; ++nt) { float v = s[nt][jj] * 0.125f;
                if (has_rel) { const int t = 16 * w + 4 * q + jj, key = 64 * j + 16 * nt + r; int rl = 512 + t - key; rl = rl > 128 ? 128 : rl; v += rel[rl + 63]; }
                s[nt][jj] = v; mx = fmaxf(mx, v); }
            mx = fmaxf(mx, __shfl_xor(mx, 1)); mx = fmaxf(mx, __shfl_xor(mx, 2)); mx = fmaxf(mx, __shfl_xor(mx, 4)); mx = fmaxf(mx, __shfl_xor(mx, 8));
            const float mn = fmaxf(mrun[jj], mx), alpha = __expf(mrun[jj] - mn); mrun[jj] = mn; float ls = lrun[jj] * alpha;
#pragma unroll
            for (int nt = 0; nt < 4; ++nt) { const float p = __expf(s[nt][jj] - mn); ls += p; Ps[(4 * q + jj) * 72 + 16 * nt + r] = f2bf(p); }
            lrun[jj] = ls;
#pragma unroll
            for (int nt = 0; nt < 4; ++nt) o[nt][jj] *= alpha;
        }
        LDSW();
#pragma unroll
        for (int ks = 0; ks < 2; ++ks) { const bf16x8 ap = *(const bf16x8*)&Ps[r * 72 + 32 * ks + 8 * q];
#pragma unroll
            for (int nt = 0; nt < 4; ++nt) { const bf16x8 bv = *(const bf16x8*)&Vt[(16 * nt + r) * 72 + 32 * ks + 8 * q]; o[nt] = MFMA16(ap, bv, o[nt]); } }
        LDSW();
    }
#pragma unroll
    for (int jj = 0; jj < 4; ++jj) { float l = lrun[jj]; l += __shfl_xor(l, 1); l += __shfl_xor(l, 2); l += __shfl_xor(l, 4); l += __shfl_xor(l, 8);
        const float inv = 1.f / l; bf16* orow = Op + (size_t)(16 * w + 4 * q + jj) * ldo + r;
#pragma unroll
        for (int nt = 0; nt < 4; ++nt) orow[16 * nt] = f2bf(o[nt][jj] * inv); }
}


__device__ __forceinline__ float xmax16(float v) { const auto rr = __builtin_amdgcn_permlane16_swap(__float_as_uint(v), __float_as_uint(v), false, false); return fmaxf(__uint_as_float(rr[0]), __uint_as_float(rr[1])); }
__device__ __forceinline__ float xmax32(float v) { const auto rr = __builtin_amdgcn_permlane32_swap(__float_as_uint(v), __float_as_uint(v), false, false); return fmaxf(__uint_as_float(rr[0]), __uint_as_float(rr[1])); }
__device__ __forceinline__ float xadd16(float v) { const auto rr = __builtin_amdgcn_permlane16_swap(__float_as_uint(v), __float_as_uint(v), false, false); return __uint_as_float(rr[0]) + __uint_as_float(rr[1]); }
__device__ __forceinline__ float xadd32(float v) { const auto rr = __builtin_amdgcn_permlane32_swap(__float_as_uint(v), __float_as_uint(v), false, false); return __uint_as_float(rr[0]) + __uint_as_float(rr[1]); }
__device__ __forceinline__ u32x4 pair16(u32x2 a, u32x2 b) {
    const auto x = __builtin_amdgcn_permlane16_swap(a.x, b.x, false, false), y = __builtin_amdgcn_permlane16_swap(a.y, b.y, false, false);
    u32x4 o; o.x = x[0]; o.y = y[0]; o.z = x[1]; o.w = y[1]; return o; }
typedef short v4i16_t __attribute__((ext_vector_type(4)));
__device__ __forceinline__ v4i16_t lds_tr16(const bf16* p) { return __builtin_amdgcn_ds_read_tr16_b64_v4i16((LAS v4i16_t*)p); }
__device__ __forceinline__ void attn256_item(char* lds, int tid, const bf16* Qw, int ldq, const bf16* Kb, const bf16* Vb, long kvrow0, int ldkv, int kc0, int kc1,
                                             int wlo, int whi, bool has_rel, int jbase, int tq0, const float* relg, bf16* Ow, int ldo) {
    const int lane = tid & 63, r = lane & 15, q = lane >> 4;
    bf16* KS = (bf16*)lds; bf16* VS = KS + 2 * 4608; float* rel = (float*)(lds + 36864);
    constexpr float LOG2E = 1.4426950408889634f, SC = 0.125f * LOG2E;
    __syncthreads();
    if (has_rel && tid < 192) rel[tid] = relg[tid] * LOG2E;
    bf16x8 bq[2][2];
#pragma unroll
    for (int mt = 0; mt < 2; ++mt)
#pragma unroll
        for (int ks = 0; ks < 2; ++ks) bq[mt][ks] = *(const bf16x8*)&Qw[(size_t)(16 * mt + r) * ldq + 32 * ks + 8 * q];
    f32x4 o[2][4]; float mrun[2], lrun[2];
#pragma unroll
    for (int mt = 0; mt < 2; ++mt) { mrun[mt] = -1e30f; lrun[mt] = 0.f;
#pragma unroll
        for (int i = 0; i < 4; ++i) o[mt][i] = (f32x4){0.f, 0.f, 0.f, 0.f}; }
    const int lrow = tid >> 3, lcv = tid & 7;
    auto attn_step = [&](const bf16* Ks, const bf16* Vs, int kc) __attribute__((always_inline)) {
        if (kc >= wlo && kc <= whi) {
            f32x4 s[2][4];
#pragma unroll
            for (int nt = 0; nt < 4; ++nt) {
#pragma unroll
                for (int mt = 0; mt < 2; ++mt) s[mt][nt] = (f32x4){0.f, 0.f, 0.f, 0.f};
#pragma unroll
                for (int ks = 0; ks < 2; ++ks) { const bf16x8 ak = *(const bf16x8*)&Ks[(16 * nt + r) * 72 + 32 * ks + 8 * q];
#pragma unroll
                    for (int mt = 0; mt < 2; ++mt) s[mt][nt] = MFMA16(ak, bq[mt][ks], s[mt][nt]); } }
            const int j = kc - jbase;
            bf16x8 pb[2][2];
#pragma unroll
            for (int mt = 0; mt < 2; ++mt) {
                float mx = -1e30f, alpha, ls = 0.f; bool rescale = true;
                if (!has_rel || j <= 5) {
                    const float cbias = has_rel ? rel[191] : 0.f;
#pragma unroll
                    for (int nt = 0; nt < 4; ++nt) mx = fmaxf(mx, fmaxf(fmaxf(s[mt][nt][0], s[mt][nt][1]), fmaxf(s[mt][nt][2], s[mt][nt][3])));
                    mx = xmax32(xmax16(mx));
                    const float cand = mx * SC + cbias; float mn = mrun[mt]; alpha = 1.f; rescale = !__all(cand - mn <= 11.5f);
                    if (rescale) { mn = fmaxf(mn, cand); alpha = __builtin_amdgcn_exp2f(mrun[mt] - mn); mrun[mt] = mn; }
                    const float off = cbias - mn;
#pragma unroll
                    for (int nt = 0; nt < 4; ++nt)
#pragma unroll
                        for (int jj = 0; jj < 4; ++jj) { const float pv = __builtin_amdgcn_exp2f(__builtin_fmaf(s[mt][nt][jj], SC, off)); s[mt][nt][jj] = pv; ls += pv; }
                } else {
#pragma unroll
                    for (int nt = 0; nt < 4; ++nt)
#pragma unroll
                        for (int jj = 0; jj < 4; ++jj) { const int t = tq0 + 16 * mt + r, key = 64 * j + 16 * nt + 4 * q + jj; int rl = 512 + t - key; rl = rl > 128 ? 128 : rl;
                            const float v = __builtin_fmaf(s[mt][nt][jj], SC, rel[rl + 63]); s[mt][nt][jj] = v; mx = fmaxf(mx, v); }
                    mx = xmax32(xmax16(mx));
                    const float mn = fmaxf(mrun[mt], mx); alpha = __builtin_amdgcn_exp2f(mrun[mt] - mn); mrun[mt] = mn;
#pragma unroll
                    for (int nt = 0; nt < 4; ++nt)
#pragma unroll
                        for (int jj = 0; jj < 4; ++jj) { const float pv = __builtin_amdgcn_exp2f(s[mt][nt][jj] - mn); s[mt][nt][jj] = pv; ls += pv; }
                }
                if (rescale) { lrun[mt] *= alpha;
#pragma unroll
                    for (int i = 0; i < 4; ++i) o[mt][i] *= alpha; }
                lrun[mt] += ls;
#pragma unroll
                for (int ks = 0; ks < 2; ++ks) { u32x4 w; w.x = pk2(s[mt][2 * ks][0], s[mt][2 * ks][1]); w.y = pk2(s[mt][2 * ks][2], s[mt][2 * ks][3]);
                    w.z = pk2(s[mt][2 * ks + 1][0], s[mt][2 * ks + 1][1]); w.w = pk2(s[mt][2 * ks + 1][2], s[mt][2 * ks + 1][3]); pb[mt][ks] = __builtin_bit_cast(bf16x8, w); }
            }
            const int qq = r >> 2, pp = r & 3;
#pragma unroll
            for (int ks = 0; ks < 2; ++ks)
#pragma unroll
                for (int nt = 0; nt < 4; ++nt) { const bf16* vp = Vs + (32 * ks + 4 * q + qq) * 72 + 16 * nt + 4 * pp;
                    const v4i16_t lo = lds_tr16(vp), hi = lds_tr16(vp + 16 * 72);
                    const bf16x8 av = {lo[0], lo[1], lo[2], lo[3], hi[0], hi[1], hi[2], hi[3]};
#pragma unroll
                    for (int mt = 0; mt < 2; ++mt) o[mt][nt] = MFMA16(av, pb[mt][ks], o[mt][nt]); }
        }
    };
    u32x4 kregA = *(const u32x4*)&Kb[(kvrow0 + 64 * kc0 + lrow) * (long)ldkv + 8 * lcv], vregA = *(const u32x4*)&Vb[(kvrow0 + 64 * kc0 + lrow) * (long)ldkv + 8 * lcv];
    u32x4 kregB = kregA, vregB = vregA;
    if (kc0 + 1 < kc1) { kregB = *(const u32x4*)&Kb[(kvrow0 + 64 * (kc0 + 1) + lrow) * (long)ldkv + 8 * lcv]; vregB = *(const u32x4*)&Vb[(kvrow0 + 64 * (kc0 + 1) + lrow) * (long)ldkv + 8 * lcv]; }
#define ATT_STEP(KREG, VREG, BUF) { \
        bf16* Ks = KS + (BUF) * 4608; bf16* Vs = VS + (BUF) * 4608; \
        *(u32x4*)&Ks[lrow * 72 + 8 * lcv] = KREG; *(u32x4*)&Vs[lrow * 72 + 8 * lcv] = VREG; \
        __syncthreads(); \
        if (kc + 2 < kc1) { KREG = *(const u32x4*)&Kb[(kvrow0 + 64 * (kc + 2) + lrow) * (long)ldkv + 8 * lcv]; VREG = *(const u32x4*)&Vb[(kvrow0 + 64 * (kc + 2) + lrow) * (long)ldkv + 8 * lcv]; } \
        attn_step(Ks, Vs, kc); }
    for (int kc = kc0; kc < kc1; kc += 2) {
        ATT_STEP(kregA, vregA, 0)
        if (kc + 1 < kc1) { ++kc; ATT_STEP(kregB, vregB, 1) --kc; }
    }
#undef ATT_STEP
#pragma unroll
    for (int mt = 0; mt < 2; ++mt) { const float l = xadd32(xadd16(lrun[mt])); const float inv = 1.f / l;
        bf16* orow = Ow + (size_t)(16 * mt + r) * ldo + 16 * (q & 1) + 8 * (q >> 1);
#pragma unroll
        for (int k = 0; k < 2; ++k) { u32x2 wa, wb; wa.x = pk2(o[mt][2 * k][0] * inv, o[mt][2 * k][1] * inv); wa.y = pk2(o[mt][2 * k][2] * inv, o[mt][2 * k][3] * inv);
            wb.x = pk2(o[mt][2 * k + 1][0] * inv, o[mt][2 * k + 1][1] * inv); wb.y = pk2(o[mt][2 * k + 1][2] * inv, o[mt][2 * k + 1][3] * inv);
            *(u32x4*)(orow + 32 * k) = pair16(wa, wb); } }
}

__device__ __forceinline__ void qk_conv8(const bf16* PA, int b, int tpos, int col, const float* cw, const float* cb, float* o8) {
    { const f32x4 b0 = *(const f32x4*)(cb + col), b1 = *(const f32x4*)(cb + col + 4); o8[0] = b0.x; o8[1] = b0.y; o8[2] = b0.z; o8[3] = b0.w; o8[4] = b1.x; o8[5] = b1.y; o8[6] = b1.z; o8[7] = b1.w; }
#pragma unroll
    for (int jj = 0; jj < 4; ++jj) { const int tt = tpos - 3 + jj;
        if (tt >= 0) { const u32x4 raw = *(const u32x4*)&PA[((size_t)b * SEQ + tt) * NPA + col]; float f[8]; unpack8(raw, f);
            const f32x4 w0 = *(const f32x4*)(cw + jj * 1536 + col), w1 = *(const f32x4*)(cw + jj * 1536 + col + 4);
            o8[0] += w0.x * f[0]; o8[1] += w0.y * f[1]; o8[2] += w0.z * f[2]; o8[3] += w0.w * f[3]; o8[4] += w1.x * f[4]; o8[5] += w1.y * f[5]; o8[6] += w1.z * f[6]; o8[7] += w1.w * f[7]; } }
#pragma unroll
    for (int e = 0; e < 8; ++e) o8[e] = siluf_(o8[e]);
}
__device__ __forceinline__ void qk_conv_rows4(const bf16* PA, int b, int tp0, int col, const float* cw, const float* cb, float scale, const float* rowscale, u32x4* outp) {
    u32x4 raw[7];
#pragma unroll
    for (int i = 0; i < 7; ++i) { const int tt = tp0 - 3 + i; raw[i] = (u32x4){0u, 0u, 0u, 0u}; if (tt >= 0) raw[i] = *(const u32x4*)&PA[((size_t)b * SEQ + tt) * NPA + col]; }
    float w[4][8], bb[8];
#pragma unroll
    for (int jj = 0; jj < 4; ++jj) { const f32x4 w0 = *(const f32x4*)(cw + jj * 1536 + col), w1 = *(const f32x4*)(cw + jj * 1536 + col + 4);
        w[jj][0] = w0.x; w[jj][1] = w0.y; w[jj][2] = w0.z; w[jj][3] = w0.w; w[jj][4] = w1.x; w[jj][5] = w1.y; w[jj][6] = w1.z; w[jj][7] = w1.w; }
    { const f32x4 b0 = *(const f32x4*)(cb + col), b1 = *(const f32x4*)(cb + col + 4); bb[0] = b0.x; bb[1] = b0.y; bb[2] = b0.z; bb[3] = b0.w; bb[4] = b1.x; bb[5] = b1.y; bb[6] = b1.z; bb[7] = b1.w; }
    float f[7][8];
#pragma unroll
    for (int i = 0; i < 7; ++i) unpack8(raw[i], f[i]);
#pragma unroll
    for (int rr = 0; rr < 4; ++rr) { float o8[8]; const float sc_ = rowscale ? scale * rowscale[rr] : scale;
#pragma unroll
        for (int e = 0; e < 8; ++e) { const float y = bb[e] + w[0][e] * f[rr][e] + w[1][e] * f[rr + 1][e] + w[2][e] * f[rr + 2][e] + w[3][e] * f[rr + 3][e]; o8[e] = siluf_(y) * sc_; }
        outp[rr] = pack8(o8); }
}
__device__ __forceinline__ void mlstm_local_unit(char* lds, int tid, int unit, const bf16* PA, const float* GT, const float* gate_b, const float* cw, const float* cb,
                                                 bf16* CS, float* DN, float* MLOC, float* BLAST) {
    const int lane = tid & 63, w = __builtin_amdgcn_readfirstlane(tid >> 6), r = lane & 15, q = lane >> 4;
    const int bh = unit >> 6, c = unit & 63, b = bh >> 2, h = bh & 3; const size_t t0 = (size_t)b * SEQ + 64 * c;
    bf16* Kn = (bf16*)lds; bf16* Vn = Kn + 64 * 200; float* ew = (float*)(lds + 2 * 25600);
    u32x4 vpre[3];
#pragma unroll
    for (int i = 0; i < 3; ++i) { const int idx = tid + 512 * i, s_ = idx / 24, dv = idx % 24; vpre[i] = *(const u32x4*)&PA[(t0 + s_) * NPA + PA_V + h * 192 + 8 * dv]; }
    __syncthreads();
    if (tid < 64) {
        const float ig = GT[(t0 + tid) * 8 + h] + gate_b[h], fg = GT[(t0 + tid) * 8 + 4 + h] + gate_b[4 + h];
        const float bc = wave_incl_sum(logsigmoidf_(fg), lane), bl = __shfl(bc, 63);
        const float wv = bl - bc + ig, ml = wave_max(wv);
        ew[tid] = __expf(wv - ml);
        if (tid == 0) { MLOC[unit] = ml; BLAST[unit] = bl; }
    }
#pragma unroll
    for (int i = 0; i < 3; ++i) { const int idx = tid + 512 * i, s_ = idx / 24, dv = idx % 24; *(u32x4*)&Vn[s_ * 200 + 8 * dv] = vpre[i]; }
    __syncthreads();
    if (tid < 384) { const int rg = tid / 24, dv = tid - 24 * rg; u32x4 o4[4];
        qk_conv_rows4(PA, b, 64 * c + 4 * rg, PA_K + h * 192 + 8 * dv, cw, cb, 0.07216878364870322f, ew + 4 * rg, o4);
#pragma unroll
        for (int rr = 0; rr < 4; ++rr) *(u32x4*)&Kn[(4 * rg + rr) * 200 + 8 * dv] = o4[rr]; }
    __syncthreads();
    {
        const int eg = w & 3, dg = w >> 2, qq = r >> 2, pp = r & 3;
        f32x4 acc[3][6];
#pragma unroll
        for (int i = 0; i < 3; ++i)
#pragma unroll
            for (int jn = 0; jn < 6; ++jn) acc[i][jn] = (f32x4){0.f, 0.f, 0.f, 0.f};
#pragma unroll
        for (int ks = 0; ks < 2; ++ks) { bf16x8 av[3];
#pragma unroll
            for (int i = 0; i < 3; ++i) { const bf16* vp = Vn + (32 * ks + 8 * q + qq) * 200 + 16 * (3 * eg + i) + 4 * pp; const v4i16_t lo = lds_tr16(vp), hi = lds_tr16(vp + 4 * 200);
                av[i] = (bf16x8){lo[0], lo[1], lo[2], lo[3], hi[0], hi[1], hi[2], hi[3]}; }
#pragma unroll
            for (int jn = 0; jn < 6; ++jn) { const bf16* kp = Kn + (32 * ks + 8 * q + qq) * 200 + 16 * (6 * dg + jn) + 4 * pp; const v4i16_t lo = lds_tr16(kp), hi = lds_tr16(kp + 4 * 200);
                const bf16x8 ak = {lo[0], lo[1], lo[2], lo[3], hi[0], hi[1], hi[2], hi[3]};
#pragma unroll
                for (int i = 0; i < 3; ++i) acc[i][jn] = MFMA16(ak, av[i], acc[i][jn]); } }
        bf16* cs = CS + (size_t)unit * 36864;
#pragma unroll
        for (int i = 0; i < 3; ++i)
#pragma unroll
            for (int jp = 0; jp < 3; ++jp) { u32x2 oa, ob; oa.x = pk2(acc[i][2 * jp][0], acc[i][2 * jp][1]); oa.y = pk2(acc[i][2 * jp][2], acc[i][2 * jp][3]);
                ob.x = pk2(acc[i][2 * jp + 1][0], acc[i][2 * jp + 1][1]); ob.y = pk2(acc[i][2 * jp + 1][2], acc[i][2 * jp + 1][3]);
                *(u32x4*)&cs[(16 * (3 * eg + i) + r) * 192 + 16 * (6 * dg + 2 * jp + (q & 1)) + 8 * (q >> 1)] = pair16(oa, ob); }
    }
    if (tid < 192) { float s0 = 0.f, s1 = 0.f;
#pragma unroll 8
        for (int k = 0; k < 64; k += 2) { s0 += bf2f(Kn[k * 200 + tid]); s1 += bf2f(Kn[(k + 1) * 200 + tid]); }
        DN[(size_t)unit * 192 + tid] = s0 + s1; }
}
__device__ __forceinline__ void mlstm_scan(int tid, bf16* CS, float* DN, const float* MLOC, const float* BLAST, float* MST) {
    const int gt = blockIdx.x * 512 + tid, NT = gridDim.x * 512;
    for (int it = gt; it < 32 * 4608 + 32 * 192; it += NT) {
        if (it < 32 * 4608) {
            const int bh = it / 4608; const size_t off = (size_t)(it % 4608) * 8; float m = 0.f; float carry[8];
#pragma unroll
            for (int e = 0; e < 8; ++e) carry[e] = 0.f;
            for (int cb = 0; cb < 8; ++cb) { u32x4 v[8];
#pragma unroll
                for (int k = 0; k < 8; ++k) v[k] = *(const u32x4*)&CS[(size_t)(bh * 64 + cb * 8 + k) * 36864 + off];
#pragma unroll
                for (int k = 0; k < 8; ++k) { const int unit = bh * 64 + cb * 8 + k; const float ml = MLOC[unit], bl = BLAST[unit];
                    const float mn = fmaxf(bl + m, ml), dec = __expf(bl + m - mn), sc = __expf(ml - mn); float f[8]; unpack8(v[k], f);
                    *(u32x4*)&CS[(size_t)unit * 36864 + off] = pack8(carry);
#pragma unroll
                    for (int e = 0; e < 8; ++e) carry[e] = dec * carry[e] + sc * f[e];
                    if (off == 0) MST[unit] = m;
                    m = mn; } }
        } else {
            const int j = it - 32 * 4608, bh = j / 192, d = j % 192; float m = 0.f, carry = 0.f;
            for (int c = 0; c < 64; ++c) { const int unit = bh * 64 + c; const float ml = MLOC[unit], bl = BLAST[unit];
                const float mn = fmaxf(bl + m, ml), dec = __expf(bl + m - mn), sc = __expf(ml - mn); const float val = DN[(size_t)unit * 192 + d];
                DN[(size_t)unit * 192 + d] = carry; carry = dec * carry + sc * val; m = mn; }
        }
    }
}
__device__ __forceinline__ void mlstm_scan256(int tid, bf16* CS, float* DN, const float* MLOC, const float* BLAST, float* MST) {
    const int bh = blockIdx.x >> 3, seg = blockIdx.x & 7; const size_t off8 = (size_t)seg * 4608 + 8 * tid, off1 = (size_t)seg * 4608 + 4096 + tid;
    const bool has_n = tid < 24; const int nidx = blockIdx.x * 24 + tid, nbh = nidx / 192, nd = nidx % 192;
    float m = 0.f, mN = 0.f, carry[8], c1 = 0.f, cn = 0.f;
#pragma unroll
    for (int e = 0; e < 8; ++e) carry[e] = 0.f;
    for (int cb = 0; cb < 8; ++cb) { u32x4 v[8]; bf16 e1[8]; float dn[8];
#pragma unroll
        for (int k = 0; k < 8; ++k) { const size_t ub = (size_t)(bh * 64 + cb * 8 + k) * 36864; v[k] = *(const u32x4*)&CS[ub + off8]; e1[k] = CS[ub + off1];
            dn[k] = has_n ? DN[(size_t)(nbh * 64 + cb * 8 + k) * 192 + nd] : 0.f; }
#pragma unroll
        for (int k = 0; k < 8; ++k) { const int unit = bh * 64 + cb * 8 + k; const float ml = MLOC[unit], bl = BLAST[unit];
            const float mn = fmaxf(bl + m, ml), dec = __expf(bl + m - mn), sc = __expf(ml - mn); float f[8]; unpack8(v[k], f);
            const size_t ub = (size_t)unit * 36864;
            *(u32x4*)&CS[ub + off8] = pack8(carry); CS[ub + off1] = f2bf(c1);
#pragma unroll
            for (int e = 0; e < 8; ++e) carry[e] = dec * carry[e] + sc * f[e];
            c1 = dec * c1 + sc * bf2f(e1[k]);
            if (seg == 0 && tid == 0) MST[unit] = m;
            m = mn;
            if (has_n) { const int un = nbh * 64 + cb * 8 + k; const float ml2 = MLOC[un], bl2 = BLAST[un]; const float mn2 = fmaxf(bl2 + mN, ml2), dec2 = __expf(bl2 + mN - mn2), sc2 = __expf(ml2 - mn2);
                DN[(size_t)un * 192 + nd] = cn; cn = dec2 * cn + sc2 * dn[k]; mN = mn2; } } }
}
__device__ __forceinline__ void mlstm_out_unit(char* lds, int tid, int unit, bf16* PA, const float* GT, const float* gate_b, const float* cw, const float* cb, const float* head_g,
                                               const bf16* CS, const float* NS, const float* MST, bf16* OB, int ldob) {
    const int lane = tid & 63, w = tid >> 6, r = lane & 15, q = lane >> 4;
    const int bh = unit >> 6, c = unit & 63, b = bh >> 2, h = bh & 3; const size_t t0 = (size_t)b * SEQ + 64 * c;
    bf16* Qs = (bf16*)lds; bf16* Ks = Qs + 64 * 200; bf16* Vt = Ks + 64 * 200; bf16* Sp = Vt + 192 * 72; float* sc = (float*)(Sp + 64 * 72);
    float* at = sc; float* gs = sc + 64; float* inter = sc + 128; float* emn = sc + 192; float* rden = sc + 256; float* nst = sc + 320;
    float* Hs = (float*)lds;
    __syncthreads();
    if (tid < 64) {
        const float ig = GT[(t0 + tid) * 8 + h] + gate_b[h], fg = GT[(t0 + tid) * 8 + 4 + h] + gate_b[4 + h];
        const float bc = wave_incl_sum(logsigmoidf_(fg), lane), g = ig - bc, pm = wave_incl_max(g, lane);
        const float mst = MST[unit], mt = bc + fmaxf(mst, pm);
        at[tid] = bc - mt; gs[tid] = g; inter[tid] = __expf(bc + mst - mt); emn[tid] = __expf(-mt);
    } else if (tid < 256) nst[tid - 64] = NS[(size_t)unit * 192 + tid - 64];
#pragma unroll
    for (int i = 0; i < 3; ++i) { const int idx = tid + 512 * i, s_ = idx / 24, dv = idx % 24; float v8[8];
        qk_conv8(PA, b, 64 * c + s_, h * 192 + 8 * dv, cw, cb, v8); *(u32x4*)&Qs[s_ * 200 + 8 * dv] = pack8(v8);
        qk_conv8(PA, b, 64 * c + s_, PA_K + h * 192 + 8 * dv, cw, cb, v8);
#pragma unroll
        for (int e = 0; e < 8; ++e) v8[e] *= 0.07216878364870322f;
        *(u32x4*)&Ks[s_ * 200 + 8 * dv] = pack8(v8); }
#pragma unroll
    for (int i = 0; i < 3; ++i) { const int idx = tid + 512 * i, s_ = idx & 63, dv = idx >> 6;
        const u32x4 v = *(const u32x4*)&PA[(t0 + s_) * NPA + PA_V + h * 192 + 8 * dv]; bf16* dvp = Vt + (8 * dv) * 72 + s_;
        dvp[0] = (bf16)(v.x & 0xffffu); dvp[72] = (bf16)(v.x >> 16); dvp[144] = (bf16)(v.y & 0xffffu); dvp[216] = (bf16)(v.y >> 16);
        dvp[288] = (bf16)(v.z & 0xffffu); dvp[360] = (bf16)(v.z >> 16); dvp[432] = (bf16)(v.w & 0xffffu); dvp[504] = (bf16)(v.w >> 16); }
    __syncthreads();
    {
        const int mt_ = w >> 1; f32x4 sa[2] = {(f32x4){0.f, 0.f, 0.f, 0.f}, (f32x4){0.f, 0.f, 0.f, 0.f}};
#pragma unroll
        for (int ks = 0; ks < 6; ++ks) { const bf16x8 a = *(const bf16x8*)&Qs[(16 * mt_ + r) * 200 + 32 * ks + 8 * q];
#pragma unroll
            for (int n2 = 0; n2 < 2; ++n2) { const int nt = (w & 1) * 2 + n2; const bf16x8 bk = *(const bf16x8*)&Ks[(16 * nt + r) * 200 + 32 * ks + 8 * q]; sa[n2] = MFMA16(a, bk, sa[n2]); } }
#pragma unroll
        for (int n2 = 0; n2 < 2; ++n2)
#pragma unroll
            for (int jj = 0; jj < 4; ++jj) { const int t = 16 * mt_ + 4 * q + jj, s_ = 16 * ((w & 1) * 2 + n2) + r;
                const float v = (s_ <= t) ? sa[n2][jj] * __expf(at[t] + gs[s_]) : 0.f; Sp[t * 72 + s_] = f2bf(v); }
    }
    __syncthreads();
    {
        const int t = tid >> 3, part = tid & 7; float a = 0.f, qn = 0.f;
#pragma unroll
        for (int k = 0; k < 8; ++k) a += bf2f(Sp[t * 72 + part * 8 + k]);
#pragma unroll
        for (int k = 0; k < 24; ++k) qn += bf2f(Qs[t * 200 + part * 24 + k]) * nst[part * 24 + k];
        a += inter[t] * qn; a += __shfl_xor(a, 1); a += __shfl_xor(a, 2); a += __shfl_xor(a, 4);
        if (part == 0) rden[t] = 1.f / fmaxf(fabsf(a), emn[t]);
    }
    {
        const int mt_ = w & 3, eg = w >> 2; f32x4 acc[6];
#pragma unroll
        for (int i = 0; i < 6; ++i) acc[i] = (f32x4){0.f, 0.f, 0.f, 0.f};
        const bf16* cs = CS + (size_t)unit * 36864;
#pragma unroll
        for (int ks = 0; ks < 6; ++ks) { const bf16x8 a = *(const bf16x8*)&Qs[(16 * mt_ + r) * 200 + 32 * ks + 8 * q];
#pragma unroll
            for (int i = 0; i < 6; ++i) { const bf16x8 bc_ = *(const bf16x8*)&cs[(16 * (6 * eg + i) + r) * 192 + 32 * ks + 8 * q]; acc[i] = MFMA16(a, bc_, acc[i]); } }
#pragma unroll
        for (int jj = 0; jj < 4; ++jj) { const float it_ = inter[16 * mt_ + 4 * q + jj];
#pragma unroll
            for (int i = 0; i < 6; ++i) acc[i][jj] *= it_; }
#pragma unroll
        for (int ks = 0; ks < 2; ++ks) { const bf16x8 a = *(const bf16x8*)&Sp[(16 * mt_ + r) * 72 + 32 * ks + 8 * q];
#pragma unroll
            for (int i = 0; i < 6; ++i) { const bf16x8 bv = *(const bf16x8*)&Vt[(16 * (6 * eg + i) + r) * 72 + 32 * ks + 8 * q]; acc[i] = MFMA16(a, bv, acc[i]); } }
        __syncthreads();
#pragma unroll
        for (int jj = 0; jj < 4; ++jj) { const int t = 16 * mt_ + 4 * q + jj; const float rd = rden[t];
#pragma unroll
            for (int i = 0; i < 6; ++i) Hs[t * 196 + 16 * (6 * eg + i) + r] = acc[i][jj] * rd; }
    }
    __syncthreads();
    {
        const int t = tid >> 3, part = tid & 7; float hv[24]; float ss = 0.f;
#pragma unroll
        for (int k = 0; k < 6; ++k) { const f32x4 x = *(const f32x4*)&Hs[t * 196 + part * 24 + 4 * k]; hv[4 * k] = x.x; hv[4 * k + 1] = x.y; hv[4 * k + 2] = x.z; hv[4 * k + 3] = x.w;
            ss += (x.x * x.x + x.y * x.y) + (x.z * x.z + x.w * x.w); }
        ss += __shfl_xor(ss, 1); ss += __shfl_xor(ss, 2); ss += __shfl_xor(ss, 4);
        const float rn = rsqrtf(ss * (1.f / 192.f) + 1e-6f);
        const bf16* op = PA + (t0 + t) * NPA + PA_O + h * 192 + part * 24; const float* hg = head_g + h * 192 + part * 24; bf16* mp = OB + (t0 + t) * ldob + h * 192 + part * 24;
#pragma unroll
        for (int k = 0; k < 3; ++k) { const u32x4 ov = *(const u32x4*)(op + 8 * k); float of[8]; unpack8(ov, of); float res[8];
#pragma unroll
            for (int e = 0; e < 8; ++e) res[e] = hv[8 * k + e] * rn * hg[8 * k + e] / (1.f + __expf(-of[e]));
            *(u32x4*)(mp + 8 * k) = pack8(res); }
    }
}
__device__ __forceinline__ void mlstm_out_pair(char* lds, int tid, int pair, bf16* PA, const float* GT, const float* gate_b, const float* cw, const float* cb, const float* head_g,
                                               const bf16* CS, const float* NS, const float* MST, bf16* OB, int ldob) {
    const int hf = tid >> 8, th = tid & 255, lane = tid & 63, wh = __builtin_amdgcn_readfirstlane(th >> 6), r = lane & 15, q = lane >> 4;
    const int unit = 2 * pair + hf;
    const int bh = unit >> 6, c = unit & 63, b = bh >> 2, h = bh & 3; const size_t t0 = (size_t)b * SEQ + 64 * c;
    char* base = lds + hf * 65536;
    bf16* Qs = (bf16*)base; bf16* Ks = Qs + 64 * 200; bf16* Vs = Ks; bf16* Sp = Ks + 64 * 200; float* sc = (float*)(Sp + 64 * 72);
    float* at = sc; float* gs = sc + 64; float* inter = sc + 128; float* emn = sc + 192; float* rden = sc + 256; float* nst = sc + 320;
    float* Hs = (float*)base;
    __syncthreads();
    if (th < 64) {
        const float ig = GT[(t0 + th) * 8 + h] + gate_b[h], fg = GT[(t0 + th) * 8 + 4 + h] + gate_b[4 + h];
        const float bc = wave_incl_sum(logsigmoidf_(fg), lane), g = ig - bc, pm = wave_incl_max(g, lane);
        const float mst = MST[unit], mt = bc + fmaxf(mst, pm);
        at[th] = bc - mt; gs[th] = g; inter[th] = __expf(bc + mst - mt); emn[th] = __expf(-mt);
    } else nst[th - 64] = NS[(size_t)unit * 192 + th - 64];
#pragma unroll 1
    for (int i = 0; i < 3; ++i) { const int task = th + 256 * i, ten = task / 384, rem = task - 384 * ten, rg = rem / 24, dv = rem - 24 * rg;
        u32x4 o4[4]; qk_conv_rows4(PA, b, 64 * c + 4 * rg, ten * PA_K + h * 192 + 8 * dv, cw, cb, ten ? 0.07216878364870322f : 1.f, nullptr, o4);
        bf16* dst = (ten ? Ks : Qs) + (4 * rg) * 200 + 8 * dv;
#pragma unroll
        for (int rr = 0; rr < 4; ++rr) *(u32x4*)&dst[rr * 200] = o4[rr]; }
    __syncthreads();
    bf16x8 bcf[6][3];
    {   const bf16* cs = CS + (size_t)unit * 36864;
#pragma unroll
        for (int ks = 0; ks < 6; ++ks)
#pragma unroll
            for (int i = 0; i < 3; ++i) bcf[ks][i] = *(const bf16x8*)&cs[(16 * (3 * wh + i) + r) * 192 + 32 * ks + 8 * q]; }
    {
        f32x4 sa[4];
#pragma unroll
        for (int nt = 0; nt < 4; ++nt) sa[nt] = (f32x4){0.f, 0.f, 0.f, 0.f};
#pragma unroll
        for (int ks = 0; ks < 6; ++ks) { const bf16x8 a = *(const bf16x8*)&Qs[(16 * wh + r) * 200 + 32 * ks + 8 * q];
#pragma unroll
            for (int nt = 0; nt < 4; ++nt) { const bf16x8 bk = *(const bf16x8*)&Ks[(16 * nt + r) * 200 + 32 * ks + 8 * q]; sa[nt] = MFMA16(a, bk, sa[nt]); } }
#pragma unroll
        for (int nt = 0; nt < 4; ++nt)
#pragma unroll
            for (int jj = 0; jj < 4; ++jj) { const int t = 16 * wh + 4 * q + jj, s_ = 16 * nt + r;
                const float v = (s_ <= t) ? sa[nt][jj] * __expf(at[t] + gs[s_]) : 0.f; Sp[t * 72 + s_] = f2bf(v); }
    }
    __syncthreads();
#pragma unroll
    for (int i = 0; i < 6; ++i) { const int idx = th + 256 * i, s_ = idx / 24, dv = idx % 24; *(u32x4*)&Vs[s_ * 200 + 8 * dv] = *(const u32x4*)&PA[(t0 + s_) * NPA + PA_V + h * 192 + 8 * dv]; }
    {
        const int t = th >> 2, part = th & 3; float a = 0.f, qn = 0.f;
#pragma unroll
        for (int k = 0; k < 2; ++k) { float f8[8]; unpack8(*(const u32x4*)&Sp[t * 72 + part * 16 + 8 * k], f8); a += ((f8[0] + f8[1]) + (f8[2] + f8[3])) + ((f8[4] + f8[5]) + (f8[6] + f8[7])); }
#pragma unroll
        for (int k = 0; k < 6; ++k) { float f8[8]; unpack8(*(const u32x4*)&Qs[t * 200 + part * 48 + 8 * k], f8); const f32x4 n0 = *(const f32x4*)&nst[part * 48 + 8 * k], n1 = *(const f32x4*)&nst[part * 48 + 8 * k + 4];
            qn += ((f8[0] * n0.x + f8[1] * n0.y) + (f8[2] * n0.z + f8[3] * n0.w)) + ((f8[4] * n1.x + f8[5] * n1.y) + (f8[6] * n1.z + f8[7] * n1.w)); }
        a += inter[t] * qn; a += __shfl_xor(a, 1); a += __shfl_xor(a, 2);
        if (part == 0) rden[t] = 1.f / fmaxf(fabsf(a), emn[t]);
    }
    f32x4 acc[4][3];
#pragma unroll
    for (int mt = 0; mt < 4; ++mt)
#pragma unroll
        for (int i = 0; i < 3; ++i) acc[mt][i] = (f32x4){0.f, 0.f, 0.f, 0.f};
    {
#pragma unroll
        for (int ks = 0; ks < 6; ++ks) {
#pragma unroll
            for (int mt = 0; mt < 4; ++mt) { const bf16x8 a = *(const bf16x8*)&Qs[(16 * mt + r) * 200 + 32 * ks + 8 * q];
#pragma unroll
                for (int i = 0; i < 3; ++i) acc[mt][i] = MFMA16(a, bcf[ks][i], acc[mt][i]); } }
#pragma unroll
        for (int mt = 0; mt < 4; ++mt)
#pragma unroll
            for (int jj = 0; jj < 4; ++jj) { const float it_ = inter[16 * mt + 4 * q + jj];
#pragma unroll
                for (int i = 0; i < 3; ++i) acc[mt][i][jj] *= it_; }
    }
    __syncthreads();
    {   const int qq = r >> 2, pp = r & 3;
#pragma unroll
        for (int ks = 0; ks < 2; ++ks) { bf16x8 bv[3];
#pragma unroll
            for (int i = 0; i < 3; ++i) { const bf16* vp = Vs + (32 * ks + 8 * q + qq) * 200 + 16 * (3 * wh + i) + 4 * pp; const v4i16_t lo = lds_tr16(vp), hi = lds_tr16(vp + 4 * 200);
                bv[i] = (bf16x8){lo[0], lo[1], lo[2], lo[3], hi[0], hi[1], hi[2], hi[3]}; }
#pragma unroll
            for (int mt = 0; mt < 4; ++mt) { const bf16x8 a = *(const bf16x8*)&Sp[(16 * mt + r) * 72 + 32 * ks + 8 * q];
#pragma unroll
                for (int i = 0; i < 3; ++i) acc[mt][i] = MFMA16(a, bv[i], acc[mt][i]); } }
    }
    __syncthreads();
#pragma unroll
    for (int mt = 0; mt < 4; ++mt)
#pragma unroll
        for (int jj = 0; jj < 4; ++jj) { const int t = 16 * mt + 4 * q + jj; const float rd = rden[t];
#pragma unroll
            for (int i = 0; i < 3; ++i) Hs[t * 196 + 16 * (3 * wh + i) + r] = acc[mt][i][jj] * rd; }
    __syncthreads();
    {
        const int t = th >> 2, part = th & 3; float ss = 0.f;
#pragma unroll
        for (int k = 0; k < 12; ++k) { const f32x4 x = *(const f32x4*)&Hs[t * 196 + part * 48 + 4 * k]; ss += (x.x * x.x + x.y * x.y) + (x.z * x.z + x.w * x.w); }
        ss += __shfl_xor(ss, 1); ss += __shfl_xor(ss, 2);
        const float rn = rsqrtf(ss * (1.f / 192.f) + 1e-6f);
        const bf16* op = PA + (t0 + t) * NPA + PA_O + h * 192 + part * 48; const float* hg = head_g + h * 192 + part * 48; bf16* mp = OB + (t0 + t) * ldob + h * 192 + part * 48;
#pragma unroll
        for (int k = 0; k < 6; ++k) { const u32x4 ov = *(const u32x4*)(op + 8 * k); float of[8]; unpack8(ov, of); float res[8];
            const f32x4 x0 = *(const f32x4*)&Hs[t * 196 + part * 48 + 8 * k], x1 = *(const f32x4*)&Hs[t * 196 + part * 48 + 8 * k + 4];
            const float hv[8] = {x0.x, x0.y, x0.z, x0.w, x1.x, x1.y, x1.z, x1.w};
            const f32x4 h0 = *(const f32x4*)(hg + 8 * k), h1 = *(const f32x4*)(hg + 8 * k + 4); const float hgv[8] = {h0.x, h0.y, h0.z, h0.w, h1.x, h1.y, h1.z, h1.w};
#pragma unroll
            for (int e = 0; e < 8; ++e) res[e] = hv[e] * rn * hgv[e] * __builtin_amdgcn_rcpf(1.f + __expf(-of[e]));
            *(u32x4*)(mp + 8 * k) = pack8(res); }
    }
}
__device__ __forceinline__ void ffn_fix(int tid, bf16* ACT, const bf16* SIDE, const float* cw, const float* cb) {
    const int gt = blockIdx.x * 512 + tid, NT = gridDim.x * 512;
    for (int it = gt; it < 512 * 352; it += NT) { const int blk = it / 352, cv = it % 352, c0 = 8 * cv; const bf16* sd = SIDE + (size_t)blk * (6 * DFF) + c0;
        float gm2[8], gm1[8], g0[8], g1[8], u0[8], u1[8], r0[8], r1[8];
        if ((blk & 63) == 0) {
#pragma unroll
            for (int e = 0; e < 8; ++e) { gm2[e] = 0.f; gm1[e] = 0.f; }
        } else { unpack8(*(const u32x4*)(sd - 6 * DFF), gm2); unpack8(*(const u32x4*)(sd - 5 * DFF), gm1); }
        unpack8(*(const u32x4*)(sd + 2 * DFF), g0); unpack8(*(const u32x4*)(sd + 3 * DFF), g1); unpack8(*(const u32x4*)(sd + 4 * DFF), u0); unpack8(*(const u32x4*)(sd + 5 * DFF), u1);
#pragma unroll
        for (int e = 0; e < 8; ++e) { const float w0 = cw[c0 + e], w1 = cw[DFF + c0 + e], w2 = cw[2 * DFF + c0 + e], bb = cb[c0 + e];
            const float y0 = w0 * gm2[e] + w1 * gm1[e] + w2 * g0[e] + bb, y1 = w0 * gm1[e] + w1 * g0[e] + w2 * g1[e] + bb; r0[e] = siluf_(y0) * u0[e]; r1[e] = siluf_(y1) * u1[e]; }
        *(u32x4*)&ACT[(size_t)(64 * blk) * DFF + c0] = pack8(r0); *(u32x4*)&ACT[(size_t)(64 * blk + 1) * DFF + c0] = pack8(r1); }
}

#define XB_TMO      128
#define XB_XCNT(j)  (256  + 64 * (j))
#define XB_XSUB(j)  (1280 + 64 * (j))
#define XB_XGEN(j)  (2304 + 64 * (j))
#define XB_TOP      3328
#define XB_TOPGEN   3392
#define XCD_BAR_WORDS 3456
#define XB_SPIN_CAP (1u << 18)

__device__ __forceinline__ unsigned xb_ld(unsigned* p)              { return __hip_atomic_load(p, __ATOMIC_RELAXED, __HIP_MEMORY_SCOPE_AGENT); }
__device__ __forceinline__ unsigned xb_add(unsigned* p, unsigned v) { return __hip_atomic_fetch_add(p, v, __ATOMIC_RELAXED, __HIP_MEMORY_SCOPE_AGENT); }
__device__ __forceinline__ unsigned xb_xcc_id() { return (unsigned)__builtin_amdgcn_s_getreg((3 << 11) | 20) & 0xFu; }
#define XB_SPIN(cond, bar) do { unsigned _sp = 0; while (cond) { __builtin_amdgcn_s_sleep(1); \
    if ((++_sp & 255u) == 0u) { if (xb_ld(&(bar)[XB_TMO])) break; if (_sp > XB_SPIN_CAP) { atomicAdd(&(bar)[XB_TMO], 1u); break; } } } } while (0)

struct XcdBarrier {
    unsigned* bar; unsigned x;
    volatile LAS unsigned* st;
};

__device__ __forceinline__ XcdBarrier xcd_barrier_post(unsigned* bar, volatile LAS unsigned* st) {
    XcdBarrier b; b.bar = bar; b.x = xb_xcc_id(); b.st = st;
    if (threadIdx.x == 0) (void)xb_add(&bar[XB_XCNT(b.x)], 1u);
    return b;
}
__device__ __forceinline__ void xcd_barrier_complete(unsigned* bar, unsigned x, unsigned& nloc, unsigned& nx) {
    const unsigned G = gridDim.x * gridDim.y * gridDim.z;
    unsigned sum, cnt, mine, sp = 0u;
    for (;;) {
        sum = 0u; cnt = 0u; mine = 0u;
#pragma unroll
        for (unsigned j = 0; j < 16; ++j) { const unsigned c = xb_ld(&bar[XB_XCNT(j)]); sum += c; cnt += (c > 0u) ? 1u : 0u; mine = (j == x) ? c : mine; }
        if (sum == G) break;
        __builtin_amdgcn_s_sleep(1);
        if ((++sp & 255u) == 0u) { if (xb_ld(&bar[XB_TMO])) break; if (sp > XB_SPIN_CAP) { atomicAdd(&bar[XB_TMO], 1u); break; } }
    }
    nloc = mine > 0u ? mine : 1u; nx = cnt > 0u ? cnt : 1u;
}

__device__ __forceinline__ void xcd_barrier(const XcdBarrier& b) {
    asm volatile("s_waitcnt vmcnt(0)" ::: "memory");
    __syncthreads();
    if (threadIdx.x == 0) {
        unsigned* bar = b.bar;
        __builtin_amdgcn_s_waitcnt(0);
        unsigned nloc = b.st[0], nx = b.st[1];
        if (nloc == 0u) { xcd_barrier_complete(bar, b.x, nloc, nx); b.st[0] = nloc; b.st[1] = nx; }
        const unsigned old = xb_add(&bar[XB_XSUB(b.x)], 1u);
        const unsigned gen = old / nloc;
        if (old + 1u == (gen + 1u) * nloc) {
            __builtin_amdgcn_fence(__ATOMIC_RELEASE, "agent");
            asm volatile("s_waitcnt vmcnt(0)" ::: "memory");
            const unsigned og = xb_add(&bar[XB_TOP], 1u);
            const unsigned tg = og / nx;
            if (og + 1u == (tg + 1u) * nx) xb_add(&bar[XB_TOPGEN], 1u);
            else XB_SPIN(xb_ld(&bar[XB_TOPGEN]) == tg, bar);
            __builtin_amdgcn_fence(__ATOMIC_ACQUIRE, "agent");
            xb_add(&bar[XB_XGEN(b.x)], 1u);
            asm volatile("s_waitcnt vmcnt(0)" ::: "memory");
        } else {
            XB_SPIN(xb_ld(&bar[XB_XGEN(b.x)]) == gen, bar);
            __builtin_amdgcn_fence(__ATOMIC_ACQUIRE, "agent");
            asm volatile("s_waitcnt vmcnt(0)" ::: "memory");
        }
    }
    __syncthreads();
}

struct Args { const float* in[21]; float* out; unsigned char* ws; int ph_lo, ph_hi, coop, pad; };

template <class Epi, bool SP2 = MK_SP2> __device__ __forceinline__ void run_gemm(unsigned char* lds, const bf16* A, int lda, const bf16* Bt, int M, int N, int K, const Epi& E, int crot = 0) {
    pg8::Gemm g{A, Bt, M, N, K, lda}; pg8::StaticOrder S; S.init(M, N, (int)gridDim.x, (int)((blockIdx.x + crot) % gridDim.x));
    pg8::gemm_phase<Epi, pg8::StaticOrder, true, SP2>((PG8_LAS unsigned char*)lds, g, S, E);
}

__global__ void __launch_bounds__(512, 2) mk_fwd(Args args) {
    extern __shared__ __attribute__((aligned(16))) unsigned char lds[];
    cg::grid_group grid = cg::this_grid();
#define PHASE_IDS() int tid = threadIdx.x; asm volatile("" : "+v"(tid)); const int lane = tid & 63, wave = __builtin_amdgcn_readfirstlane(tid >> 6), gw = bid * 8 + wave; (void)lane; (void)gw
    const int G = gridDim.x, bid = blockIdx.x;
    unsigned char* ws = args.ws;
    const float* x = args.in[0]; const float* mem = args.in[1]; const float* norm_mix_g = args.in[2]; const float* norm_ffn_g = args.in[3];
    const float* a_w_in = args.in[4]; const float* a_gate_b = args.in[5]; const float* a_conv_w = args.in[6]; const float* a_conv_b = args.in[7];
    const float* a_head_g = args.in[8]; const float* a_w_out = args.in[9]; const float* kv_norm_g = args.in[10]; const float* w_kv = args.in[11];
    const float* b_w_in = args.in[12]; const float* b_rel = args.in[13]; const float* b_w_out = args.in[14]; const float* mem_w_kv = args.in[15];
    const float* ffn_w_up = args.in[16]; const float* ffn_conv_w = args.in[17]; const float* ffn_conv_b = args.in[18]; const float* ffn_w_down = args.in[19];
    const float* final_g = args.in[20];
    float* out = args.out;
    bf16* WAIN = (bf16*)(ws + WS_WAIN); bf16* WAOUT = (bf16*)(ws + WS_WAOUT); bf16* WB = (bf16*)(ws + WS_WB); bf16* WBOUT = (bf16*)(ws + WS_WBOUT); bf16* WM = (bf16*)(ws + WS_WM);

    bf16* MEMB = (bf16*)(ws + WS_MEMB); bf16* MKV = (bf16*)(ws + WS_MKV); float* DN = (float*)(ws + WS_DN);
    float* MLOC = (float*)(ws + WS_SC); float* BLAST = MLOC + 2048; float* MST = MLOC + 4096;
    bf16* XN = (bf16*)(ws + WS_XN); bf16* MIXB = (bf16*)(ws + WS_MIXB); float* SSQ = (float*)(ws + WS_SSQ); float* GATES = (float*)(ws + WS_GATES);
    bf16* PA = (bf16*)(ws + WS_PA); bf16* CS = (bf16*)(ws + WS_CS); bf16* U = (bf16*)(ws + WS_U); bf16* Gb = (bf16*)(ws + WS_G); bf16* PB = (bf16*)(ws + WS_PB);
    const int lo = args.ph_lo, hi = args.ph_hi; const bool coop = args.coop != 0;
    if (threadIdx.x < 64) ((LAS unsigned*)((LAS unsigned char*)lds + 131072))[threadIdx.x] = 0u;
    __syncthreads();
    XcdBarrier bar; bar.bar = (unsigned*)ws; bar.x = 0; bar.st = nullptr;
    if (coop) bar = xcd_barrier_post((unsigned*)ws, (volatile LAS unsigned*)((LAS unsigned char*)lds + 131072 + 32));
    if (args.coop == 2) grid.sync();
    const int NGW = G * 8;
#define IN(k) (lo <= (k) && (k) < hi)
#define REPS(k) ((k) == MK_REP ? MK_NREP : 1)
#define SEAM(k) do { if (coop && IN(k) && IN((k) + 1)) xcd_barrier(bar); } while (0)

    if (IN(0)) for (int rep_ = 0; rep_ < REPS(0); ++rep_) { PHASE_IDS();
        float* scr = (float*)(lds + wave * 16384);
        for (int it = gw; it < 12928; it += NGW) { int r = it;
            if (r < 1664) { tr_item(a_w_in, 1024, 3336, norm_mix_g, WAIN, 1, r, 104, scr, lane); continue; } r -= 1664;
            if (r < 512) { tr_item(a_w_out, 1024, 1024, nullptr, WAOUT, 0, r, 32, scr, lane); continue; } r -= 512;
            if (r < 512) { tr_item(b_w_in, 1024, 1024, norm_mix_g + 1024, WB, 0, r, 32, scr, lane); continue; } r -= 512;
            if (r < 768) { tr_item(w_kv, 1024, 1536, kv_norm_g, WB + (size_t)1024 * 1024, 0, r, 48, scr, lane); continue; } r -= 768;
            if (r < 512) { tr_item(b_w_out, 1024, 1024, nullptr, WBOUT, 0, r, 32, scr, lane); continue; } r -= 512;
            if (r < 256) { tr_item(mem_w_kv, 1024, 512, nullptr, WM, 0, r, 16, scr, lane); continue; } r -= 256;
            if (r < 256) { tr_item(mem_w_kv + (size_t)1024 * 512, 1024, 512, nullptr, WM + (size_t)512 * 1024, 0, r, 16, scr, lane); continue; } r -= 256;
            if (r < 2816) { tr_item(ffn_w_up, 1024, 5632, norm_ffn_g, (bf16*)(ws + WS_WUP0), 2, r, 176, scr, lane); continue; } r -= 2816;
            if (r < 2816) { tr_item(ffn_w_up + (size_t)1024 * 5632, 1024, 5632, norm_ffn_g + 1024, (bf16*)(ws + WS_WUP1), 2, r, 176, scr, lane); continue; } r -= 2816;
            if (r < 1408) { tr_item(ffn_w_down, 2816, 1024, nullptr, (bf16*)(ws + WS_WDN0), 0, r, 32, scr, lane); continue; } r -= 1408;
            tr_item(ffn_w_down + (size_t)2816 * 1024, 2816, 1024, nullptr, (bf16*)(ws + WS_WDN1), 0, r, 32, scr, lane);
        }
        __syncthreads();
        {   float* wg = (float*)lds;
            for (int e = tid; e < 8192; e += 512) { const int k = e >> 3, c = e & 7; wg[c * 1024 + k] = a_w_in[(size_t)k * 3336 + 3072 + c] * norm_mix_g[k]; }
            __syncthreads();
            for (int m = 2 * gw; m < MTOK; m += 2 * NGW) row2_gates(x + (size_t)m * DM, XN + (size_t)m * DM, GATES + (size_t)m * 8, wg, lane); }
        for (int m = gw; m < NB * 256; m += NGW) row_to_bf16<false>(mem + (size_t)m * DM, MEMB + (size_t)m * DM, lane);
    }
    SEAM(0);
    if (IN(1)) for (int rep_ = 0; rep_ < REPS(1); ++rep_) {
        { pg8::EpiBf16 E{MKV, 1024, 0, 0, nullptr}; run_gemm(lds, MEMB, 1024, WM, NB * 256, 1024, 1024, E, G / 2); }
        { pg8::EpiBf16 E{PA, NPA, 0, 0, nullptr}; run_gemm(lds, XN, 1024, WAIN, MTOK, 3328, 1024, E); }
    }
    SEAM(1);
    if (IN(2)) for (int rep_ = 0; rep_ < REPS(2); ++rep_) { PHASE_IDS();
        for (int u = bid; u < 2048; u += G) mlstm_local_unit((char*)lds, tid, u, PA, GATES, a_gate_b, a_conv_w, a_conv_b, CS, DN, MLOC, BLAST);
        for (int it = bid; it < 512; it += G) { const int h = it & 3, g = (it >> 2) & 15, b = it >> 6; const size_t tw = (size_t)b * SEQ + 256 * g + 32 * wave;
            attn256_item((char*)lds, tid, PA + tw * NPA + PA_QM + 64 * h, NPA, MKV + 64 * h, MKV + 256 + 64 * h, (long)b * 256, 1024, 0, 4, 0, 3, false, 0, 0, nullptr, rep_ == 0 ? PA + tw * NPA + PA_QM + 64 * h : (bf16*)out + tw * DM + 64 * h, rep_ == 0 ? NPA : DM); }
    }
    SEAM(2);
    if (IN(3)) { PHASE_IDS(); if (G == 256) mlstm_scan256(tid, CS, DN, MLOC, BLAST, MST); else mlstm_scan(tid, CS, DN, MLOC, BLAST, MST); }
    SEAM(3);
    if (IN(4)) for (int rep_ = 0; rep_ < REPS(4); ++rep_) { PHASE_IDS(); for (int u = bid; u < 1024; u += G) mlstm_out_pair((char*)lds, tid, u, PA, GATES, a_gate_b, a_conv_w, a_conv_b, a_head_g, CS, DN, MST, rep_ == 0 ? PA + PA_O : (bf16*)out, rep_ == 0 ? NPA : 1024); }
    SEAM(4);
    if (IN(5)) for (int rep_ = 0; rep_ < REPS(5); ++rep_) { pg8::EpiRes<true> E{x, XN, DM, SSQ}; run_gemm(lds, PA + PA_O, NPA, WAOUT, MTOK, DM, DM, E); }
    SEAM(5);
#pragma unroll 1
    for (int l = 0; l < 2; ++l) {
        const int pb = 6 + 8 * l;
        if (IN(pb + 1)) { pg8::EpiAct E{U, Gb, SSQ, ffn_conv_w + (size_t)l * 3 * DFF, ffn_conv_b + (size_t)l * DFF}; run_gemm<pg8::EpiAct, true>(lds, XN, 1024, (bf16*)(ws + WS_WUP0 + (size_t)l * (WS_WUP1 - WS_WUP0)), MTOK, 2 * DFF, DM, E); }
        SEAM(pb + 1);
        if (IN(pb + 2)) { PHASE_IDS(); ffn_fix(tid, U, Gb, ffn_conv_w + (size_t)l * 3 * DFF, ffn_conv_b + (size_t)l * DFF); }
        SEAM(pb + 2);
        if (IN(pb + 3)) { pg8::EpiRes<false> E{nullptr, XN, DM, SSQ}; run_gemm(lds, U, DFF, (bf16*)(ws + WS_WDN0 + (size_t)l * (WS_WDN1 - WS_WDN0)), MTOK, DM, DFF, E); }
        SEAM(pb + 3);
        if (l == 0) {
            if (IN(11)) for (int rep_ = 0; rep_ < REPS(11); ++rep_) { pg8::EpiBf16 E{PB, NPB, 0, 0, SSQ}; run_gemm(lds, XN, 1024, WB, MTOK, NPB, DM, E); }
            SEAM(11);
            if (IN(12)) for (int rep_ = 0; rep_ < REPS(12); ++rep_) { PHASE_IDS();
                for (int it = bid; it < 1536; it += G) { const int h = it % 12, g = (it / 12) & 15, b = it / 192, w = wave, cq = 4 * g + (w >> 1); const size_t tw = (size_t)b * SEQ + 256 * g + 32 * w;
                    attn256_item((char*)lds, tid, PB + tw * NPB + 64 * h, NPB, PB + PB_K + 64 * h, PB + PB_V + 64 * h, (long)b * SEQ, NPB, g >= 2 ? 4 * g - 8 : 0, 4 * g + 4,
                                 cq >= 8 ? cq - 8 : 0, cq, true, cq - 8, 32 * (w & 1), b_rel + h * 192, MIXB + tw * DM + 64 * h, DM); }
                for (int it = bid; it < 512; it += G) { const int h = it & 3, g = (it >> 2) & 15, b = it >> 6; const size_t tw = (size_t)b * SEQ + 256 * g + 32 * wave;
                    attn256_item((char*)lds, tid, PB + tw * NPB + PB_QM + 64 * h, NPB, MKV + 512 + 64 * h, MKV + 768 + 64 * h, (long)b * 256, 1024, 0, 4, 0, 3, false, 0, 0, nullptr, MIXB + tw * DM + 768 + 64 * h, DM); }
            }
            SEAM(12);
            if (IN(13)) { pg8::EpiRes<false> E{nullptr, XN, DM, SSQ}; run_gemm(lds, MIXB, 1024, WBOUT, MTOK, DM, DM, E); }
            SEAM(13);
        }
    }
    if (IN(18)) { PHASE_IDS(); for (int m = gw; m < MTOK; m += NGW) final_norm_row(XN + (size_t)m * DM, SSQ + (size_t)m * 16, out + (size_t)m * DM, final_g, lane); }
#undef IN
#undef SEAM
}

#ifndef MK_MULTI
#define MK_MULTI 0
#endif
extern "C" void kernel_launch(void* const* d_in, const int* in_sizes, int n_in, void* d_out, int out_size, void* d_ws, size_t ws_size, hipStream_t stream) {
    static int grid = 0;
    if (grid == 0) {
        if (n_in != 21 || out_size != MTOK * DM || ws_size < WS_END) { fprintf(stderr, "kernel_launch: unexpected shapes (n_in %d out %d ws %zu)\n", n_in, out_size, ws_size); grid = -1; return; }
        int dev = 0, cus = 0, per_cu = 0;
        (void)hipGetDevice(&dev); (void)hipDeviceGetAttribute(&cus, hipDeviceAttributeMultiprocessorCount, dev);
        if (hipFuncSetAttribute((const void*)mk_fwd, hipFuncAttributeMaxDynamicSharedMemorySize, LDS_BYTES) != hipSuccess) { fprintf(stderr, "kernel_launch: hipFuncSetAttribute failed\n"); grid = -1; return; }
        if (hipOccupancyMaxActiveBlocksPerMultiprocessor(&per_cu, (const void*)mk_fwd, 512, LDS_BYTES) != hipSuccess || per_cu < 1) { fprintf(stderr, "kernel_launch: occupancy query says %d\n", per_cu); per_cu = 1; }
        (void)hipGetLastError();
        grid = cus * 1;
    }
    if (grid < 0) return;
    Args a{};
    for (int i = 0; i < 21; ++i) a.in[i] = (const float*)d_in[i];
    a.out = (float*)d_out; a.ws = (unsigned char*)d_ws;
#if MK_MULTI
    for (int p = 0; p < NPHASE; ++p) { a.ph_lo = p; a.ph_hi = p + 1; a.coop = 0; hipLaunchKernelGGL(mk_fwd, dim3(grid), dim3(512), LDS_BYTES, stream, a); }
#else
    a.ph_lo = 0; a.ph_hi = NPHASE; a.coop = 1;
    if (hipMemsetAsync(d_ws, 0, 65536, stream) != hipSuccess) { fprintf(stderr, "kernel_launch: memset failed\n"); return; }
    void* kargs[] = {&a};
    hipError_t e = hipLaunchCooperativeKernel((const void*)mk_fwd, dim3(grid), dim3(512), kargs, LDS_BYTES, stream);
    if (e != hipSuccess) fprintf(stderr, "kernel_launch: cooperative launch failed: %s (grid %d)\n", hipGetErrorString(e), grid);
#endif
}
```

```cpp
#include <hip/hip_runtime.h>
#include <hip/hip_cooperative_groups.h>
#include <cstdio>
#include <cstdint>
namespace cg = cooperative_groups;
namespace pg8 {
#define PG8_LAS __attribute__((address_space(3)))
typedef unsigned short bf16_t;
typedef short bf16x8 __attribute__((ext_vector_type(8)));
typedef float f32x4 __attribute__((ext_vector_type(4)));
typedef unsigned u32x4 __attribute__((ext_vector_type(4)));
constexpr int BM = 256, BK = 64, HALF = 128, HTB = HALF * BK * 2  , STAGE_BYTES = 8 * HTB, NXCD = 8, WGM = 8;

__host__ __device__ __forceinline__ int lds_byte(int r, int c) { const int st = (r >> 4) * 2 + (c >> 5), rr = r & 15, cc = c & 31, ob = rr * 64 + cc * 2; return st * 1024 + (ob ^ (((ob >> 9) & 1) << 5)); }
__host__ __device__ __forceinline__ void stage_rc(int b, int& R, int& C) { const int st = b / 1024, sb = b % 1024, swz = sb ^ (((sb >> 9) & 1) << 5); R = (st >> 1) * 16 + swz / 64; C = (st & 1) * 32 + (swz % 64) / 2; }
__host__ __device__ __forceinline__ int perm32(int rho) { const int n = rho >> 4, i = rho & 15; return 8 * (i >> 2) + 4 * n + (i & 3); }

struct Unit { int pm, pn; };
struct Gemm { const bf16_t* A; const bf16_t* Bt; int M, N, K, lda; };

struct StaticOrder {
    int nM, nN, nwg, G, c;
    __host__ __device__ void init(int M, int N, int G_, int c_) { nM = M / BM; nN = N / BM; nwg = nM * nN; G = G_; c = c_; }
    __host__ __device__ bool next(int i, Unit& u) const {
        const long L = (long)i * G + c; if (L >= nwg) return false;
        int wgid = (int)L; { const int q = nwg / NXCD, r = nwg % NXCD, xcd = wgid % NXCD, off = wgid / NXCD; wgid = (xcd < r ? xcd * (q + 1) : r * (q + 1) + (xcd - r) * q) + off; }
        const int nig = WGM * nN, gid = wgid / nig, fm = gid * WGM, gsz = (nM - fm) < WGM ? (nM - fm) : WGM;
        u.pm = fm + ((wgid % nig) % gsz); u.pn = (wgid % nig) / gsz; return true;
    }
    __device__ __forceinline__ void a_ready(const Unit&) const {}
    __device__ __forceinline__ void done(const Unit&) const {}
};

__device__ __forceinline__ unsigned cvt_pk_bf16(float lo, float hi) { unsigned r; asm volatile("v_cvt_pk_bf16_f32 %0, %1, %2" : "=v"(r) : "v"(lo), "v"(hi)); return r; }
typedef float f32x2 __attribute__((ext_vector_type(2)));
struct EpiBf16 {
    static constexpr bool PERM = true, AFTER_DRAIN = false;
    bf16_t* O; int ldc; int split_cols; size_t split_stride; const float* ssq;
    __device__ __forceinline__ void operator()(const f32x4 (&acc)[2][2][4][2], const Unit& u, int wr, int wc, int fr, int fq) const {
        const int row0 = u.pm * BM + wr * 64 + fr; int colt = u.pn * BM; bf16_t* base = O;
        if (split_cols) { const int t = colt / split_cols; base += (size_t)t * split_stride; colt -= t * split_cols; }
        const int col0 = colt + wc * 32 + 8 * fq;
        float rs[2][4];
#pragma unroll
        for (int ai = 0; ai < 2; ++ai)
#pragma unroll
            for (int m = 0; m < 4; ++m) { rs[ai][m] = 1.f;
                if (ssq) { const f32x4 a = *((const f32x4*)(ssq + (size_t)(row0 + ai * HALF + m * 16) * 16) + fq);
                    float t = (a[0] + a[1]) + (a[2] + a[3]); t += __shfl_xor(t, 16); t += __shfl_xor(t, 32);
                    rs[ai][m] = rsqrtf(t * (1.f / 1024.f) + 1e-6f); } }
#pragma unroll
        for (int ai = 0; ai < 2; ++ai)
#pragma unroll
            for (int m = 0; m < 4; ++m) { bf16_t* rowp = base + (size_t)(row0 + ai * HALF + m * 16) * ldc + col0; const float r_ = rs[ai][m];
#pragma unroll
                for (int bj = 0; bj < 2; ++bj) { const f32x4 v0 = acc[ai][bj][m][0] * r_, v1 = acc[ai][bj][m][1] * r_;
                    u32x4 w; w.x = cvt_pk_bf16(v0[0], v0[1]); w.y = cvt_pk_bf16(v0[2], v0[3]); w.z = cvt_pk_bf16(v1[0], v1[1]); w.w = cvt_pk_bf16(v1[2], v1[3]);
                    *(u32x4*)(rowp + bj * HALF) = w; } }
    }
};
__device__ __forceinline__ float dpp_ror1(float v) { return __int_as_float(__builtin_amdgcn_update_dpp(0, __float_as_int(v), 0x121, 0xf, 0xf, true)); }
__device__ __forceinline__ float dpp_ror2(float v) { return __int_as_float(__builtin_amdgcn_update_dpp(0, __float_as_int(v), 0x122, 0xf, 0xf, true)); }
struct EpiAct {
    static constexpr bool PERM = true, AFTER_DRAIN = false;
    bf16_t* ACT; bf16_t* SIDE; const float* ssq; const float* cw; const float* cb;
    __device__ __forceinline__ void operator()(const f32x4 (&acc)[2][2][4][2], const Unit& u, int wr, int wc, int fr, int fq) const {
        const int ch0 = u.pn * 128 + wc * 32 + 8 * fq;
        float rs[2][4];
#pragma unroll
        for (int ai = 0; ai < 2; ++ai)
#pragma unroll
            for (int m = 0; m < 4; ++m) { const f32x4 a = *((const f32x4*)(ssq + (size_t)(u.pm * BM + ai * HALF + wr * 64 + m * 16 + fr) * 16) + fq);
                float t = (a[0] + a[1]) + (a[2] + a[3]); t += __shfl_xor(t, 16); t += __shfl_xor(t, 32);
                rs[ai][m] = rsqrtf(t * (1.f / 1024.f) + 1e-6f); }
        typedef unsigned u32x2v __attribute__((ext_vector_type(2)));
        char* const actb = (char*)(ACT + (size_t)(u.pm * BM + wr * 64 + fr) * 2816 + ch0);
        char* const sideb = (char*)(SIDE + (size_t)(u.pm * 4 + wr) * (6 * 2816) + ch0);
        u32x2v keep[2][4];
#pragma unroll
        for (int n = 0; n < 2; ++n) {
            const int ch = ch0 + 4 * n;
            const f32x4 w0 = *(const f32x4*)(cw + ch) * -1.4426950408889634f, w1 = *(const f32x4*)(cw + 2816 + ch) * -1.4426950408889634f, w2 = *(const f32x4*)(cw + 5632 + ch) * -1.4426950408889634f,
                        bb = *(const f32x4*)(cb + ch) * -1.4426950408889634f;
#pragma unroll
            for (int ai = 0; ai < 2; ++ai) {
                f32x4 gp1 = {0.f, 0.f, 0.f, 0.f}, gp2 = {0.f, 0.f, 0.f, 0.f};
#pragma unroll
                for (int m = 0; m < 4; ++m) { const float r_ = rs[ai][m];
                    unsigned aoff = (unsigned)((ai * HALF + m * 16) * 2816 * 2 + n * 8), soff = (unsigned)(ai * 2 * 6 * 2816 * 2 + n * 8);
                    asm volatile("" : "+s"(aoff), "+s"(soff));
                    const f32x4 gc = acc[ai][1][m][n] * r_, uu = acc[ai][0][m][n] * (r_ * -0.6931471805599453f); f32x4 c1, c2, res;
#pragma unroll
                    for (int k = 0; k < 4; ++k) { c1[k] = dpp_ror1(gc[k]); c2[k] = dpp_ror2(gc[k]); }
#pragma unroll
                    for (int k = 0; k < 4; ++k) { const float p1 = fr >= 1 ? c1[k] : gp1[k], p2 = fr >= 2 ? c2[k] : gp2[k];
                        const float y = __builtin_fmaf(w0[k], p2, __builtin_fmaf(w1[k], p1, __builtin_fmaf(w2[k], gc[k], bb[k]))); res[k] = (y * uu[k]) * __builtin_amdgcn_rcpf(1.f + __builtin_amdgcn_exp2f(y)); }
                    gp1 = c1; gp2 = c2;
                    u32x2v w; w.x = cvt_pk_bf16(res[0], res[1]); w.y = cvt_pk_bf16(res[2], res[3]);
                    u32x2v wg; wg.x = cvt_pk_bf16(gc[0], gc[1]); wg.y = cvt_pk_bf16(gc[2], gc[3]);
                    char* const side = sideb + soff;
                    if (m == 0 && fr < 2) { const f32x4 up = acc[ai][0][m][n] * r_; u32x2v wu; wu.x = cvt_pk_bf16(up[0], up[1]); wu.y = cvt_pk_bf16(up[2], up[3]);
                        *(u32x2v*)(side + (2 + fr) * 5632) = wg; *(u32x2v*)(side + (4 + fr) * 5632) = wu; }
                    else if (n == 0) keep[ai][m] = w;
                    else { u32x4 w4; w4.x = keep[ai][m].x; w4.y = keep[ai][m].y; w4.z = w.x; w4.w = w.y; *(u32x4*)(actb + aoff - 8) = w4; }
                    if (m == 3 && fr >= 14) *(u32x2v*)(side + (fr - 14) * 5632) = wg;
                    __builtin_amdgcn_sched_barrier(0);
                }
            }
        }
    }
};
template <bool BASE32> struct EpiRes {
    static constexpr bool PERM = true, AFTER_DRAIN = false;
    const float* base32; bf16_t* xn; int ldc; float* ssq;
    __device__ __forceinline__ void operator()(const f32x4 (&acc)[2][2][4][2], const Unit& u, int wr, int wc, int fr, int fq) const {
        const int col0 = u.pn * BM + wc * 32 + 8 * fq;
#pragma unroll
        for (int ai = 0; ai < 2; ++ai) {
            f32x4 b0[4][2], b1[4][2];
#pragma unroll
            for (int m = 0; m < 4; ++m) { const size_t off = (size_t)(u.pm * BM + ai * HALF + wr * 64 + m * 16 + fr) * ldc + col0;
#pragma unroll
                for (int bj = 0; bj < 2; ++bj) { const size_t p = off + bj * HALF;
                    if (BASE32) { b0[m][bj] = *(const f32x4*)(base32 + p); b1[m][bj] = *(const f32x4*)(base32 + p + 4); }
                    else { const u32x4 r = *(const u32x4*)(xn + p);
                        b0[m][bj] = (f32x4){__uint_as_float(r.x << 16), __uint_as_float(r.x & 0xffff0000u), __uint_as_float(r.y << 16), __uint_as_float(r.y & 0xffff0000u)};
                        b1[m][bj] = (f32x4){__uint_as_float(r.z << 16), __uint_as_float(r.z & 0xffff0000u), __uint_as_float(r.w << 16), __uint_as_float(r.w & 0xffff0000u)}; } } }
#pragma unroll
            for (int m = 0; m < 4; ++m) { const int row = u.pm * BM + ai * HALF + wr * 64 + m * 16 + fr; const size_t off = (size_t)row * ldc + col0; float sq = 0.f;
#pragma unroll
                for (int bj = 0; bj < 2; ++bj) { const size_t p = off + bj * HALF;
                    const f32x4 o0 = b0[m][bj] + acc[ai][bj][m][0], o1 = b1[m][bj] + acc[ai][bj][m][1];
                    u32x4 w; w.x = cvt_pk_bf16(o0[0], o0[1]); w.y = cvt_pk_bf16(o0[2], o0[3]); w.z = cvt_pk_bf16(o1[0], o1[1]); w.w = cvt_pk_bf16(o1[2], o1[3]); *(u32x4*)(xn + p) = w;
                    const float q0 = __uint_as_float(w.x << 16), q1 = __uint_as_float(w.x & 0xffff0000u), q2 = __uint_as_float(w.y << 16), q3 = __uint_as_float(w.y & 0xffff0000u);
                    const float q4 = __uint_as_float(w.z << 16), q5 = __uint_as_float(w.z & 0xffff0000u), q6 = __uint_as_float(w.w << 16), q7 = __uint_as_float(w.w & 0xffff0000u);
                    sq += ((q0 * q0 + q1 * q1) + (q2 * q2 + q3 * q3)) + ((q4 * q4 + q5 * q5) + (q6 * q6 + q7 * q7)); }
                sq += __shfl_xor(sq, 16); sq += __shfl_xor(sq, 32);
                if (fq == 0) ssq[(size_t)row * 16 + u.pn * 4 + wc] = sq; }
            asm volatile("" ::: "memory");
        }
    }
};
template <class Epi, class Sched, bool ALIGN_EPI = false, bool SP2 = false>
__device__ __forceinline__ void gemm_phase(PG8_LAS unsigned char* lds, const Gemm g, const Sched& S, const Epi& E) {
    int tid_ = threadIdx.x; asm volatile("" : "+v"(tid_));
    const int tid = tid_, wid = __builtin_amdgcn_readfirstlane(tid >> 6), lane = tid & 63, wr = wid >> 2, wc = wid & 3, fr = lane & 15, fq = lane >> 4;
    const int K = g.K, nt = K / BK;
    unsigned voffA[2], voffB[2];
#pragma unroll
    for (int i = 0; i < 2; ++i) { int R, C; stage_rc(tid * 16 + i * 8192, R, C); const int Rb = Epi::PERM ? ((R & ~31) + perm32(R & 31)) : R;
        voffA[i] = (unsigned)(R * g.lda + C) * 2u; voffB[i] = (unsigned)(Rb * K + C) * 2u; }
    const size_t kstep = (size_t)(BK * 2);
    const size_t hstep = (size_t)HALF * K * 2;
    const size_t tstep = 2 * hstep;
    const size_t hstepA = (size_t)HALF * g.lda * 2, tstepA = 2 * hstepA;
    const unsigned ldsw = (unsigned)wid * 1024u;
    const int aoff = lds_byte(wr * 64 + fr, fq * 8), boff = lds_byte(wc * 32 + fr, fq * 8);
#define PG8_SA(b, h) (((b) * 2 + (h)) * HTB)
#define PG8_SB(b, h) ((4 + (b) * 2 + (h)) * HTB)
#define PG8_STAGE(bufoff, gbase, voff) do { _Pragma("unroll") for (int _i = 0; _i < 2; ++_i) \
        __builtin_amdgcn_global_load_lds((const unsigned*)((const char*)(gbase) + (voff)[_i]), (PG8_LAS unsigned*)(lds + (bufoff) + ldsw + _i * 8192), 16, 0, 0); } while (0)
#define PG8_LDA(dst, b, h) do { _Pragma("unroll") for (int m = 0; m < 4; ++m) _Pragma("unroll") for (int k = 0; k < 2; ++k) dst[m][k] = *(const PG8_LAS bf16x8*)(lds + PG8_SA(b, h) + aoff + m * 2048 + k * 1024); } while (0)
#define PG8_LDB(dst, b, h) do { _Pragma("unroll") for (int n = 0; n < 2; ++n) _Pragma("unroll") for (int k = 0; k < 2; ++k) dst[n][k] = *(const PG8_LAS bf16x8*)(lds + PG8_SB(b, h) + boff + n * 2048 + k * 1024); } while (0)
#define PG8_MMA(ai, bj, At, Bt) do { __builtin_amdgcn_s_setprio(1); _Pragma("unroll") for (int m = 0; m < 4; ++m) _Pragma("unroll") for (int n = 0; n < 2; ++n) _Pragma("unroll") for (int k = 0; k < 2; ++k) \
        acc[ai][bj][m][n] = __builtin_amdgcn_mfma_f32_16x16x32_bf16(Bt[n][k], At[m][k], acc[ai][bj][m][n], 0, 0, 0); __builtin_amdgcn_s_setprio(0); } while (0)
#define PG8_WAIT_V(n) asm volatile("s_waitcnt vmcnt(" #n ")" ::: "memory")
#define PG8_WAIT_L(n) asm volatile("s_waitcnt lgkmcnt(" #n ")" ::: "memory")
#define PG8_BAR __builtin_amdgcn_s_barrier()
#define PG8_SCHED __builtin_amdgcn_sched_barrier(0)
    Unit cur, nxt; int ui = 0;
    if (!S.next(0, cur)) return;
    f32x4 acc[2][2][4][2];
#pragma unroll
    for (int a = 0; a < 2; ++a)
#pragma unroll
        for (int b = 0; b < 2; ++b)
#pragma unroll
            for (int m = 0; m < 4; ++m)
#pragma unroll
                for (int n = 0; n < 2; ++n) acc[a][b][m][n] = (f32x4){0.f, 0.f, 0.f, 0.f};
    bf16x8 At[4][2], B0[2][2], B1[2][2];
    const char* cA = (const char*)g.A + (size_t)cur.pm * tstepA; const char* cB = (const char*)g.Bt + (size_t)cur.pn * tstep;
    S.a_ready(cur);
    if constexpr (SP2) {
        PG8_STAGE(PG8_SB(0, 0), cB, voffB); PG8_STAGE(PG8_SB(0, 1), cB + hstep, voffB); PG8_STAGE(PG8_SA(0, 0), cA, voffA); PG8_STAGE(PG8_SA(0, 1), cA + hstepA, voffA);
        if (wr == 1) PG8_BAR;
        PG8_WAIT_V(2); PG8_BAR;
        PG8_STAGE(PG8_SB(1, 0), cB + kstep, voffB); PG8_STAGE(PG8_SA(1, 0), cA + kstep, voffA); PG8_STAGE(PG8_SB(1, 1), cB + hstep + kstep, voffB);
        PG8_WAIT_V(6); PG8_BAR;
    } else {
        PG8_STAGE(PG8_SB(0, 0), cB, voffB); PG8_STAGE(PG8_SA(0, 0), cA, voffA); PG8_STAGE(PG8_SB(0, 1), cB + hstep, voffB); PG8_STAGE(PG8_SA(0, 1), cA + hstepA, voffA);
        if (wr == 1) PG8_BAR;
        PG8_WAIT_V(4); PG8_BAR;
        PG8_STAGE(PG8_SB(1, 0), cB + kstep, voffB); PG8_STAGE(PG8_SA(1, 0), cA + kstep, voffA); PG8_STAGE(PG8_SB(1, 1), cB + hstep + kstep, voffB);
        PG8_WAIT_V(6); PG8_BAR;
    }
    for (;;) {
        const bool has_next = S.next(ui + 1, nxt);
        const char* nA = has_next ? (const char*)g.A + (size_t)nxt.pm * tstepA : cA; const char* nB = has_next ? (const char*)g.Bt + (size_t)nxt.pn * tstep : cB;
        for (int t = 0; t < nt; t += 2) {
            const bool last = (t == nt - 2);
            const char* a1 = cA + (size_t)(t + 1) * kstep;
            const char* a2 = last ? nA : cA + (size_t)(t + 2) * kstep; const char* b2 = last ? nB : cB + (size_t)(t + 2) * kstep;
            const char* a3 = a2 + kstep; const char* b3 = b2 + kstep;
            if (last && has_next) S.a_ready(nxt);
            if constexpr (SP2) {
            PG8_LDB(B0, 0, 0); PG8_LDB(B1, 0, 1); PG8_SCHED; PG8_LDA(At, 0, 0); PG8_STAGE(PG8_SA(1, 1), a1 + hstepA, voffA);
            PG8_WAIT_V(8); PG8_WAIT_L(0); PG8_BAR; PG8_MMA(0, 0, At, B0); PG8_MMA(0, 1, At, B1); PG8_BAR; PG8_SCHED;
            PG8_LDA(At, 0, 1); PG8_STAGE(PG8_SB(0, 0), b2, voffB); PG8_STAGE(PG8_SB(0, 1), b2 + hstep, voffB); PG8_STAGE(PG8_SA(0, 0), a2, voffA);
            PG8_WAIT_V(8); PG8_WAIT_L(0); PG8_BAR; PG8_MMA(1, 0, At, B0); PG8_MMA(1, 1, At, B1); PG8_BAR; PG8_SCHED;
            PG8_LDB(B0, 1, 0); PG8_LDB(B1, 1, 1); PG8_SCHED; PG8_LDA(At, 1, 0); PG8_STAGE(PG8_SA(0, 1), a2 + hstepA, voffA);
            PG8_WAIT_V(8); PG8_WAIT_L(0); PG8_BAR; PG8_MMA(0, 0, At, B0); PG8_MMA(0, 1, At, B1); PG8_BAR; PG8_SCHED;
            PG8_LDA(At, 1, 1); PG8_STAGE(PG8_SB(1, 0), b3, voffB); PG8_STAGE(PG8_SB(1, 1), b3 + hstep, voffB); PG8_STAGE(PG8_SA(1, 0), a3, voffA);
            PG8_WAIT_V(8); PG8_WAIT_L(0); PG8_BAR; PG8_MMA(1, 0, At, B0); PG8_MMA(1, 1, At, B1); PG8_BAR; PG8_SCHED;
            } else {
            PG8_LDB(B0, 0, 0); PG8_SCHED; PG8_LDA(At, 0, 0); PG8_STAGE(PG8_SA(1, 1), a1 + hstepA, voffA);
            PG8_WAIT_L(8); PG8_BAR; PG8_WAIT_L(0); PG8_MMA(0, 0, At, B0); PG8_BAR; PG8_SCHED;
            PG8_LDB(B1, 0, 1); PG8_STAGE(PG8_SB(0, 0), b2, voffB);
            PG8_BAR; PG8_WAIT_L(0); PG8_MMA(0, 1, At, B1); PG8_BAR;
            PG8_LDA(At, 0, 1); PG8_STAGE(PG8_SA(0, 0), a2, voffA);
            PG8_BAR; PG8_WAIT_L(0); PG8_MMA(1, 0, At, B0); PG8_BAR; PG8_SCHED;
            PG8_STAGE(PG8_SB(0, 1), b2 + hstep, voffB);
            PG8_WAIT_V(6); PG8_BAR; PG8_MMA(1, 1, At, B1); PG8_BAR;
            PG8_LDB(B0, 1, 0); PG8_SCHED; PG8_LDA(At, 1, 0); PG8_STAGE(PG8_SA(0, 1), a2 + hstepA, voffA);
            PG8_WAIT_L(8); PG8_BAR; PG8_WAIT_L(0); PG8_MMA(0, 0, At, B0); PG8_BAR; PG8_SCHED;
            PG8_LDB(B1, 1, 1); PG8_STAGE(PG8_SB(1, 0), b3, voffB);
            PG8_BAR; PG8_WAIT_L(0); PG8_MMA(0, 1, At, B1); PG8_BAR;
            PG8_LDA(At, 1, 1); PG8_STAGE(PG8_SA(1, 0), a3, voffA);
            PG8_BAR; PG8_WAIT_L(0); PG8_MMA(1, 0, At, B0); PG8_BAR; PG8_SCHED;
            PG8_STAGE(PG8_SB(1, 1), b3 + hstep, voffB);
            PG8_WAIT_V(6); PG8_BAR; PG8_MMA(1, 1, At, B1); PG8_BAR;
            }
        }
        if constexpr (ALIGN_EPI) { if (wr == 0) PG8_BAR; }
        if constexpr (!Epi::AFTER_DRAIN) { E(acc, cur, wr, wc, fr, fq); S.done(cur); }
        if (!has_next) break;
#pragma unroll
        for (int a = 0; a < 2; ++a)
#pragma unroll
            for (int b = 0; b < 2; ++b)
#pragma unroll
                for (int m = 0; m < 4; ++m)
#pragma unroll
                    for (int n = 0; n < 2; ++n) acc[a][b][m][n] = (f32x4){0.f, 0.f, 0.f, 0.f};
        cur = nxt; cA = nA; cB = nB; ++ui;
        if constexpr (ALIGN_EPI) { if (wr == 1) PG8_BAR; }
    }
    PG8_WAIT_V(0);
    if constexpr (!ALIGN_EPI) { if (wr == 0) PG8_BAR; }
    PG8_BAR;
    if constexpr (Epi::AFTER_DRAIN) { E.fused(acc, cur, wr, wc, fr, fq, lds, wid, lane); S.done(cur); }
#undef PG8_SA
#undef PG8_SB
#undef PG8_STAGE
#undef PG8_LDA
#undef PG8_LDB
#undef PG8_MMA
#undef PG8_WAIT_V
#undef PG8_WAIT_L
#undef PG8_BAR
#undef PG8_SCHED
}
}

typedef unsigned short bf16;
typedef short bf16x8 __attribute__((ext_vector_type(8)));
typedef float f32x4 __attribute__((ext_vector_type(4)));
typedef unsigned u32x4 __attribute__((ext_vector_type(4)));
typedef unsigned u32x2 __attribute__((ext_vector_type(2)));
#define LAS __attribute__((address_space(3)))

constexpr int NB = 8, SEQ = 4096, DM = 1024, MTOK = NB * SEQ;
constexpr int NPA = 3584, NPB = 2560, DFF = 2816;
constexpr int PA_K = 768, PA_V = 1536, PA_O = 2304, PA_QM = 3072, PA_G = 3328;
constexpr int PB_QM = 768, PB_K = 1024, PB_V = 1792;
constexpr size_t MiB = 1u << 20;
constexpr size_t WS_WAIN = 1 * MiB, WS_WAOUT = 8 * MiB, WS_WB = 10 * MiB, WS_WBOUT = 15 * MiB, WS_WM = 17 * MiB, WS_WUP0 = 19 * MiB, WS_WUP1 = 30 * MiB,
                 WS_WDN0 = 41 * MiB, WS_WDN1 = 47 * MiB, WS_MEMB = 53 * MiB, WS_MKV = 57 * MiB, WS_DN = 61 * MiB, WS_SC = 63 * MiB, WS_XN = 64 * MiB, WS_BIG = 128 * MiB;
constexpr size_t WS_GATES = 498 * MiB;
constexpr size_t WS_SSQ = 496 * MiB, WS_MIXB = WS_BIG + 160 * MiB;
constexpr size_t WS_PA = WS_BIG, WS_CS = WS_BIG + 224 * MiB, WS_U = WS_BIG, WS_G = WS_BIG + 176 * MiB, WS_PB = WS_BIG, WS_END = 499 * MiB;
constexpr int LDS_BYTES = 147456;
constexpr int NPHASE = 19;
#ifndef MK_REP
#define MK_REP -1
#define MK_NREP 1
#endif
#ifndef MK_SP2
#define MK_SP2 true
#endif

__device__ __forceinline__ float bf2f(bf16 h) { return __uint_as_float((unsigned)h << 16); }
typedef float f32x2_t __attribute__((ext_vector_type(2)));
typedef __bf16 bf16x2_t __attribute__((ext_vector_type(2)));
__device__ __forceinline__ unsigned pk2(float lo, float hi) { const f32x2_t v = {lo, hi}; const bf16x2_t b = __builtin_convertvector(v, bf16x2_t); return __builtin_bit_cast(unsigned, b); }
__device__ __forceinline__ bf16 f2bf(float f) { return (bf16)(pk2(f, f) & 0xffffu); }
__device__ __forceinline__ void unpack8(const u32x4 w, float* f) {
    f[0] = __uint_as_float(w.x << 16); f[1] = __uint_as_float(w.x & 0xffff0000u); f[2] = __uint_as_float(w.y << 16); f[3] = __uint_as_float(w.y & 0xffff0000u);
    f[4] = __uint_as_float(w.z << 16); f[5] = __uint_as_float(w.z & 0xffff0000u); f[6] = __uint_as_float(w.w << 16); f[7] = __uint_as_float(w.w & 0xffff0000u); }
__device__ __forceinline__ u32x4 pack8(const float* f) { u32x4 o; o.x = pk2(f[0], f[1]); o.y = pk2(f[2], f[3]); o.z = pk2(f[4], f[5]); o.w = pk2(f[6], f[7]); return o; }
__device__ __forceinline__ float wave_sum(float v) {
#pragma unroll
    for (int o = 1; o < 64; o <<= 1) v += __shfl_xor(v, o);
    return v; }
__device__ __forceinline__ float wave_max(float v) {
#pragma unroll
    for (int o = 1; o < 64; o <<= 1) v = fmaxf(v, __shfl_xor(v, o));
    return v; }
__device__ __forceinline__ float wave_incl_sum(float x, int lane) {
#pragma unroll
    for (int o = 1; o < 64; o <<= 1) { const float v = __shfl_up(x, o); if (lane >= o) x += v; }
    return x; }
__device__ __forceinline__ float wave_incl_max(float x, int lane) {
#pragma unroll
    for (int o = 1; o < 64; o <<= 1) { const float v = __shfl_up(x, o); if (lane >= o) x = fmaxf(x, v); }
    return x; }
__device__ __forceinline__ float logsigmoidf_(float x) { return fminf(x, 0.f) - log1pf(__expf(-fabsf(x))); }
__device__ __forceinline__ float siluf_(float x) { return x * __builtin_amdgcn_rcpf(1.f + __expf(-x)); }
#define MFMA16(a, b, c) __builtin_amdgcn_mfma_f32_16x16x32_bf16((a), (b), (c), 0, 0, 0)
#define LDSW() asm volatile("s_waitcnt lgkmcnt(0)" ::: "memory")

__device__ __forceinline__ int src_col_ain(int nd) { return nd < 3072 ? nd : nd + 8; }
__device__ __forceinline__ void tr_item(const float* __restrict__ W, int K, int ldw, const float* __restrict__ gain, bf16* WT, int mode, int item, int nblk, float* scr, int lane) {
    const int kb = item / nblk, nb = item % nblk, k0 = 64 * kb, nd0 = 32 * nb;
    const int krow = lane >> 3, c4 = lane & 7, nd = nd0 + 4 * c4;
    const int sc = mode == 1 ? src_col_ain(nd) : (mode == 2 ? ((nd >> 7) & 1) * 2816 + (nd >> 8) * 128 + (nd & 127) : nd);
#pragma unroll
    for (int i = 0; i < 8; ++i) { const int kk = 8 * i + krow; f32x4 v = {0.f, 0.f, 0.f, 0.f};
        if (sc >= 0) { v = *(const f32x4*)&W[(size_t)(k0 + kk) * ldw + sc]; if (gain) v = v * gain[k0 + kk]; }
        float* d = scr + kk * 33 + 4 * c4; d[0] = v.x; d[1] = v.y; d[2] = v.z; d[3] = v.w; }
    LDSW();
    const int c = lane & 7;
#pragma unroll
    for (int j = 0; j < 4; ++j) { const int n = (lane >> 3) + 8 * j; const float* s = scr + (8 * c) * 33 + n;
        u32x4 o; o.x = pk2(s[0], s[33]); o.y = pk2(s[66], s[99]); o.z = pk2(s[132], s[165]); o.w = pk2(s[198], s[231]);
        *(u32x4*)(WT + (size_t)(nd0 + n) * K + k0 + 8 * c) = o; }
    LDSW();
}
template <bool NORM> __device__ __forceinline__ void row_to_bf16(const float* xrow, bf16* orow, int lane) {
    const f32x4* xr = (const f32x4*)xrow + lane; f32x4 v[4]; float s = 0.f;
#pragma unroll
    for (int j = 0; j < 4; ++j) { v[j] = xr[64 * j]; s += (v[j].x * v[j].x + v[j].y * v[j].y) + (v[j].z * v[j].z + v[j].w * v[j].w); }
    float rs = 1.f;
    if (NORM) rs = rsqrtf(wave_sum(s) * (1.f / 1024.f) + 1e-6f);
    u32x2* o = (u32x2*)orow + lane;
#pragma unroll
    for (int j = 0; j < 4; ++j) { u32x2 t; t.x = pk2(v[j].x * rs, v[j].y * rs); t.y = pk2(v[j].z * rs, v[j].w * rs); o[64 * j] = t; }
}
__device__ __forceinline__ void row2_to_bf16(const float* xrow, bf16* orow, int lane) {
    const f32x4* xr = (const f32x4*)xrow + lane; f32x4 v[2][4]; float s0 = 0.f, s1 = 0.f;
#pragma unroll
    for (int j = 0; j < 4; ++j) { v[0][j] = xr[64 * j]; v[1][j] = xr[256 + 64 * j]; }
#pragma unroll
    for (int j = 0; j < 4; ++j) { s0 += (v[0][j].x * v[0][j].x + v[0][j].y * v[0][j].y) + (v[0][j].z * v[0][j].z + v[0][j].w * v[0][j].w);
        s1 += (v[1][j].x * v[1][j].x + v[1][j].y * v[1][j].y) + (v[1][j].z * v[1][j].z + v[1][j].w * v[1][j].w); }
#pragma unroll
    for (int o = 1; o < 64; o <<= 1) { s0 += __shfl_xor(s0, o); s1 += __shfl_xor(s1, o); }
    const float r0 = rsqrtf(s0 * (1.f / 1024.f) + 1e-6f), r1 = rsqrtf(s1 * (1.f / 1024.f) + 1e-6f);
    u32x2* o = (u32x2*)orow + lane;
#pragma unroll
    for (int j = 0; j < 4; ++j) { u32x2 t; t.x = pk2(v[0][j].x * r0, v[0][j].y * r0); t.y = pk2(v[0][j].z * r0, v[0][j].w * r0); o[64 * j] = t;
        u32x2 t1; t1.x = pk2(v[1][j].x * r1, v[1][j].y * r1); t1.y = pk2(v[1][j].z * r1, v[1][j].w * r1); o[256 + 64 * j] = t1; }
}
__device__ __forceinline__ void row2_gates(const float* xrow, bf16* orow, float* grow, const float* wg, int lane) {
    f32x4 v[2][4]; float s0 = 0.f, s1 = 0.f;
#pragma unroll
    for (int j = 0; j < 2; ++j) { const f32x4* p0 = (const f32x4*)(xrow + 8 * lane + 512 * j); const f32x4* p1 = (const f32x4*)(xrow + 1024 + 8 * lane + 512 * j);
        v[0][2 * j] = p0[0]; v[0][2 * j + 1] = p0[1]; v[1][2 * j] = p1[0]; v[1][2 * j + 1] = p1[1]; }
#pragma unroll
    for (int j = 0; j < 4; ++j) { s0 += (v[0][j].x * v[0][j].x + v[0][j].y * v[0][j].y) + (v[0][j].z * v[0][j].z + v[0][j].w * v[0][j].w);
        s1 += (v[1][j].x * v[1][j].x + v[1][j].y * v[1][j].y) + (v[1][j].z * v[1][j].z + v[1][j].w * v[1][j].w); }
    float g0[8], g1[8];
#pragma unroll
    for (int c = 0; c < 8; ++c) { float a0 = 0.f, a1 = 0.f;
#pragma unroll
        for (int j = 0; j < 4; ++j) { const f32x4 w = *(const f32x4*)(wg + c * 1024 + 8 * lane + 512 * (j >> 1) + 4 * (j & 1));
            a0 += (v[0][j].x * w.x + v[0][j].y * w.y) + (v[0][j].z * w.z + v[0][j].w * w.w); a1 += (v[1][j].x * w.x + v[1][j].y * w.y) + (v[1][j].z * w.z + v[1][j].w * w.w); }
        g0[c] = a0; g1[c] = a1; }
#pragma unroll
    for (int o = 1; o < 64; o <<= 1) { s0 += __shfl_xor(s0, o); s1 += __shfl_xor(s1, o); }
    float gv[16];
#pragma unroll
    for (int c = 0; c < 8; ++c) { gv[c] = g0[c]; gv[8 + c] = g1[c]; }
    { const bool hb = (lane & 32) != 0;
#pragma unroll
      for (int i = 0; i < 8; ++i) { const float send = hb ? gv[i] : gv[i + 8], keep = hb ? gv[i + 8] : gv[i]; gv[i] = keep + __shfl_xor(send, 32); } }
    { const bool hb = (lane & 16) != 0;
#pragma unroll
      for (int i = 0; i < 4; ++i) { const float send = hb ? gv[i] : gv[i + 4], keep = hb ? gv[i + 4] : gv[i]; gv[i] = keep + __shfl_xor(send, 16); } }
    { const bool hb = (lane & 8) != 0;
#pragma unroll
      for (int i = 0; i < 2; ++i) { const float send = hb ? gv[i] : gv[i + 2], keep = hb ? gv[i + 2] : gv[i]; gv[i] = keep + __shfl_xor(send, 8); } }
    { const bool hb = (lane & 4) != 0; const float send = hb ? gv[0] : gv[1], keep = hb ? gv[1] : gv[0]; gv[0] = keep + __shfl_xor(send, 4); }
    gv[0] += __shfl_xor(gv[0], 2); gv[0] += __shfl_xor(gv[0], 1);
    const float r0 = rsqrtf(s0 * (1.f / 1024.f) + 1e-6f), r1 = rsqrtf(s1 * (1.f / 1024.f) + 1e-6f);
#pragma unroll
    for (int j = 0; j < 2; ++j) { u32x4 t0, t1;
        t0.x = pk2(v[0][2 * j].x * r0, v[0][2 * j].y * r0); t0.y = pk2(v[0][2 * j].z * r0, v[0][2 * j].w * r0); t0.z = pk2(v[0][2 * j + 1].x * r0, v[0][2 * j + 1].y * r0); t0.w = pk2(v[0][2 * j + 1].z * r0, v[0][2 * j + 1].w * r0);
        t1.x = pk2(v[1][2 * j].x * r1, v[1][2 * j].y * r1); t1.y = pk2(v[1][2 * j].z * r1, v[1][2 * j].w * r1); t1.z = pk2(v[1][2 * j + 1].x * r1, v[1][2 * j + 1].y * r1); t1.w = pk2(v[1][2 * j + 1].z * r1, v[1][2 * j + 1].w * r1);
        *(u32x4*)(orow + 8 * lane + 512 * j) = t0; *(u32x4*)(orow + 1024 + 8 * lane + 512 * j) = t1; }
    if ((lane & 3) == 0) grow[lane >> 2] = gv[0] * ((lane & 32) ? r1 : r0);
}
__device__ __forceinline__ void final_norm_row(const bf16* xrow, const float* ssq16, float* orow, const float* g, int lane) {
    const f32x4* sp = (const f32x4*)ssq16; const f32x4 a = sp[0], b = sp[1], c = sp[2], d = sp[3];
    const float t = ((a[0] + a[1]) + (a[2] + a[3])) + ((b[0] + b[1]) + (b[2] + b[3])) + ((c[0] + c[1]) + (c[2] + c[3])) + ((d[0] + d[1]) + (d[2] + d[3]));
    const float rs = rsqrtf(t * (1.f / 1024.f) + 1e-6f);
#pragma unroll
    for (int j = 0; j < 2; ++j) { const u32x4 r = *((const u32x4*)xrow + lane + 64 * j); float f[8]; unpack8(r, f);
        const f32x4 g0 = *((const f32x4*)g + 2 * (lane + 64 * j)), g1 = *((const f32x4*)g + 2 * (lane + 64 * j) + 1);
        f32x4 o0 = {f[0] * rs * g0.x, f[1] * rs * g0.y, f[2] * rs * g0.z, f[3] * rs * g0.w}, o1 = {f[4] * rs * g1.x, f[5] * rs * g1.y, f[6] * rs * g1.z, f[7] * rs * g1.w};
        *((f32x4*)orow + 2 * (lane + 64 * j)) = o0; *((f32x4*)orow + 2 * (lane + 64 * j) + 1) = o1; }
}

__device__ __forceinline__ void attn_item(char* lds, int tid, const bf16* Qp, int ldq, const bf16* Kb, const bf16* Vb, long krow0, int ldkv, int nkc, int jfirst,
                                          const float* relg, bf16* Op, int ldo) {
    const int hf = tid >> 8, th = tid & 255, w = th >> 6, lane = tid & 63, r = lane & 15, q = lane >> 4;
    char* base = lds + hf * 40960;
    bf16* Qs = (bf16*)base; bf16* Ks = Qs + 4608; bf16* Vt = Ks + 4608; bf16* Ps = Vt + 4608 + w * 1152; float* rel = (float*)(base + 36864);
    __syncthreads();
#pragma unroll
    for (int i = 0; i < 2; ++i) { const int idx = th + 256 * i, row = idx >> 3, cv = idx & 7; *(u32x4*)&Qs[row * 72 + 8 * cv] = *(const u32x4*)&Qp[(size_t)row * ldq + 8 * cv]; }
    const bool has_rel = relg != nullptr;
    if (has_rel && th < 192) rel[th] = relg[th];
    f32x4 o[4]; float mrun[4], lrun[4];
#pragma unroll
    for (int i = 0; i < 4; ++i) { o[i] = (f32x4){0.f, 0.f, 0.f, 0.f}; mrun[i] = -1e30f; lrun[i] = 0.f; }
    for (int j = jfirst; j < nkc; ++j) {
        __syncthreads();
        const bf16* Kj = Kb + (krow0 + 64 * j) * (long)ldkv; const bf16* Vj = Vb + (krow0 + 64 * j) * (long)ldkv;
#pragma unroll
        for (int i = 0; i < 2; ++i) { const int idx = th + 256 * i, row = idx >> 3, cv = idx & 7; *(u32x4*)&Ks[row * 72 + 8 * cv] = *(const u32x4*)&Kj[(size_t)row * ldkv + 8 * cv]; }
#pragma unroll
        for (int i = 0; i < 2; ++i) { const int idx = th + 256 * i, s_ = idx & 63, cv = idx >> 6; const u32x4 v = *(const u32x4*)&Vj[(size_t)s_ * ldkv + 8 * cv];
            bf16* d = Vt + (8 * cv) * 72 + s_;
            d[0] = (bf16)(v.x & 0xffffu); d[72] = (bf16)(v.x >> 16); d[144] = (bf16)(v.y & 0xffffu); d[216] = (bf16)(v.y >> 16);
            d[288] = (bf16)(v.z & 0xffffu); d[360] = (bf16)(v.z >> 16); d[432] = (bf16)(v.w & 0xffffu); d[504] = (bf16)(v.w >> 16); }
        __syncthreads();
        bf16x8 aq[2];
#pragma unroll
        for (int ks = 0; ks < 2; ++ks) aq[ks] = *(const bf16x8*)&Qs[(16 * w + r) * 72 + 32 * ks + 8 * q];
        f32x4 s[4];
#pragma unroll
        for (int nt = 0; nt < 4; ++nt) { s[nt] = (f32x4){0.f, 0.f, 0.f, 0.f};
#pragma unroll
            for (int ks = 0; ks < 2; ++ks) { const bf16x8 bk = *(const bf16x8*)&Ks[(16 * nt + r) * 72 + 32 * ks + 8 * q]; s[nt] = MFMA16(aq[ks], bk, s[nt]); } }
#pragma unroll
        for (int jj = 0; jj < 4; ++jj) {
            float mx = -1e30f;
#pragma unroll
            for (int nt = 0; nt < 4; ++nt) { float v = s[nt][jj] * 0.125f;
                if (has_rel) { const int t = 16 * w + 4 * q + jj, key = 64 * j + 16 * nt + r; int rl = 512 + t - key; rl = rl > 128 ? 128 : rl; v += rel[rl + 63]; }
                s[nt][jj] = v; mx = fmaxf(mx, v); }
            mx = fmaxf(mx, __shfl_xor(mx, 1)); mx = fmaxf(mx, __shfl_xor(mx, 2)); mx = fmaxf(mx, __shfl_xor(mx, 4)); mx = fmaxf(mx, __shfl_xor(mx, 8));
            const float mn = fmaxf(mrun[jj], mx), alpha = __expf(mrun[jj] - mn); mrun[jj] = mn; float ls = lrun[jj] * alpha;
#pragma unroll
            for (int nt = 0; nt < 4; ++nt) { const float p = __expf(s[nt][jj] - mn); ls += p; Ps[(4 * q + jj) * 72 + 16 * nt + r] = f2bf(p); }
            lrun[jj] = ls;
#pragma unroll
            for (int nt = 0; nt < 4; ++nt) o[nt][jj] *= alpha;
        }
        LDSW();
#pragma unroll
        for (int ks = 0; ks < 2; ++ks) { const bf16x8 ap = *(const bf16x8*)&Ps[r * 72 + 32 * ks + 8 * q];
#pragma unroll
            for (int nt = 0; nt < 4; ++nt) { const bf16x8 bv = *(const bf16x8*)&Vt[(16 * nt + r) * 72 + 32 * ks + 8 * q]; o[nt] = MFMA16(ap, bv, o[nt]); } }
        LDSW();
    }
#pragma unroll
    for (int jj = 0; jj < 4; ++jj) { float l = lrun[jj]; l += __shfl_xor(l, 1); l += __shfl_xor(l, 2); l += __shfl_xor(l, 4); l += __shfl_xor(l, 8);
        const float inv = 1.f / l; bf16* orow = Op + (size_t)(16 * w + 4 * q + jj) * ldo + r;
#pragma unroll
        for (int nt = 0; nt < 4; ++nt) orow[16 * nt] = f2bf(o[nt][jj] * inv); }
}


__device__ __forceinline__ float xmax16(float v) { const auto rr = __builtin_amdgcn_permlane16_swap(__float_as_uint(v), __float_as_uint(v), false, false); return fmaxf(__uint_as_float(rr[0]), __uint_as_float(rr[1])); }
__device__ __forceinline__ float xmax32(float v) { const auto rr = __builtin_amdgcn_permlane32_swap(__float_as_uint(v), __float_as_uint(v), false, false); return fmaxf(__uint_as_float(rr[0]), __uint_as_float(rr[1])); }
__device__ __forceinline__ float xadd16(float v) { const auto rr = __builtin_amdgcn_permlane16_swap(__float_as_uint(v), __float_as_uint(v), false, false); return __uint_as_float(rr[0]) + __uint_as_float(rr[1]); }
__device__ __forceinline__ float xadd32(float v) { const auto rr = __builtin_amdgcn_permlane32_swap(__float_as_uint(v), __float_as_uint(v), false, false); return __uint_as_float(rr[0]) + __uint_as_float(rr[1]); }
__device__ __forceinline__ u32x4 pair16(u32x2 a, u32x2 b) {
    const auto x = __builtin_amdgcn_permlane16_swap(a.x, b.x, false, false), y = __builtin_amdgcn_permlane16_swap(a.y, b.y, false, false);
    u32x4 o; o.x = x[0]; o.y = y[0]; o.z = x[1]; o.w = y[1]; return o; }
typedef short v4i16_t __attribute__((ext_vector_type(4)));
__device__ __forceinline__ v4i16_t lds_tr16(const bf16* p) { return __builtin_amdgcn_ds_read_tr16_b64_v4i16((LAS v4i16_t*)p); }
__device__ __forceinline__ void attn256_item(char* lds, int tid, const bf16* Qw, int ldq, const bf16* Kb, const bf16* Vb, long kvrow0, int ldkv, int kc0, int kc1,
                                             int wlo, int whi, bool has_rel, int jbase, int tq0, const float* relg, bf16* Ow, int ldo) {
    const int lane = tid & 63, r = lane & 15, q = lane >> 4;
    bf16* KS = (bf16*)lds; bf16* VS = KS + 2 * 4608; float* rel = (float*)(lds + 36864);
    constexpr float LOG2E = 1.4426950408889634f, SC = 0.125f * LOG2E;
    __syncthreads();
    if (has_rel && tid < 192) rel[tid] = relg[tid] * LOG2E;
    bf16x8 bq[2][2];
#pragma unroll
    for (int mt = 0; mt < 2; ++mt)
#pragma unroll
        for (int ks = 0; ks < 2; ++ks) bq[mt][ks] = *(const bf16x8*)&Qw[(size_t)(16 * mt + r) * ldq + 32 * ks + 8 * q];
    f32x4 o[2][4]; float mrun[2], lrun[2];
#pragma unroll
    for (int mt = 0; mt < 2; ++mt) { mrun[mt] = -1e30f; lrun[mt] = 0.f;
#pragma unroll
        for (int i = 0; i < 4; ++i) o[mt][i] = (f32x4){0.f, 0.f, 0.f, 0.f}; }
    const int lrow = tid >> 3, lcv = tid & 7;
    auto attn_step = [&](const bf16* Ks, const bf16* Vs, int kc) __attribute__((always_inline)) {
        if (kc >= wlo && kc <= whi) {
            f32x4 s[2][4];
#pragma unroll
            for (int nt = 0; nt < 4; ++nt) {
#pragma unroll
                for (int mt = 0; mt < 2; ++mt) s[mt][nt] = (f32x4){0.f, 0.f, 0.f, 0.f};
#pragma unroll
                for (int ks = 0; ks < 2; ++ks) { const bf16x8 ak = *(const bf16x8*)&Ks[(16 * nt + r) * 72 + 32 * ks + 8 * q];
#pragma unroll
                    for (int mt = 0; mt < 2; ++mt) s[mt][nt] = MFMA16(ak, bq[mt][ks], s[mt][nt]); } }
            const int j = kc - jbase;
            bf16x8 pb[2][2];
#pragma unroll
            for (int mt = 0; mt < 2; ++mt) {
                float mx = -1e30f, alpha, ls = 0.f; bool rescale = true;
                if (!has_rel || j <= 5) {
                    const float cbias = has_rel ? rel[191] : 0.f;
#pragma unroll
                    for (int nt = 0; nt < 4; ++nt) mx = fmaxf(mx, fmaxf(fmaxf(s[mt][nt][0], s[mt][nt][1]), fmaxf(s[mt][nt][2], s[mt][nt][3])));
                    mx = xmax32(xmax16(mx));
                    const float cand = mx * SC + cbias; float mn = mrun[mt]; alpha = 1.f; rescale = !__all(cand - mn <= 11.5f);
                    if (rescale) { mn = fmaxf(mn, cand); alpha = __builtin_amdgcn_exp2f(mrun[mt] - mn); mrun[mt] = mn; }
                    const float off = cbias - mn;
#pragma unroll
                    for (int nt = 0; nt < 4; ++nt)
#pragma unroll
                        for (int jj = 0; jj < 4; ++jj) { const float pv = __builtin_amdgcn_exp2f(__builtin_fmaf(s[mt][nt][jj], SC, off)); s[mt][nt][jj] = pv; ls += pv; }
                } else {
#pragma unroll
                    for (int nt = 0; nt < 4; ++nt)
#pragma unroll
                        for (int jj = 0; jj < 4; ++jj) { const int t = tq0 + 16 * mt + r, key = 64 * j + 16 * nt + 4 * q + jj; int rl = 512 + t - key; rl = rl > 128 ? 128 : rl;
                            const float v = __builtin_fmaf(s[mt][nt][jj], SC, rel[rl + 63]); s[mt][nt][jj] = v; mx = fmaxf(mx, v); }
                    mx = xmax32(xmax16(mx));
                    const float mn = fmaxf(mrun[mt], mx); alpha = __builtin_amdgcn_exp2f(mrun[mt] - mn); mrun[mt] = mn;
#pragma unroll
                    for (int nt = 0; nt < 4; ++nt)
#pragma unroll
                        for (int jj = 0; jj < 4; ++jj) { const float pv = __builtin_amdgcn_exp2f(s[mt][nt][jj] - mn); s[mt][nt][jj] = pv; ls += pv; }
                }
                if (rescale) { lrun[mt] *= alpha;
#pragma unroll
                    for (int i = 0; i < 4; ++i) o[mt][i] *= alpha; }
                lrun[mt] += ls;
#pragma unroll
                for (int ks = 0; ks < 2; ++ks) { u32x4 w; w.x = pk2(s[mt][2 * ks][0], s[mt][2 * ks][1]); w.y = pk2(s[mt][2 * ks][2], s[mt][2 * ks][3]);
                    w.z = pk2(s[mt][2 * ks + 1][0], s[mt][2 * ks + 1][1]); w.w = pk2(s[mt][2 * ks + 1][2], s[mt][2 * ks + 1][3]); pb[mt][ks] = __builtin_bit_cast(bf16x8, w); }
            }
            const int qq = r >> 2, pp = r & 3;
#pragma unroll
            for (int ks = 0; ks < 2; ++ks)
#pragma unroll
                for (int nt = 0; nt < 4; ++nt) { const bf16* vp = Vs + (32 * ks + 4 * q + qq) * 72 + 16 * nt + 4 * pp;
                    const v4i16_t lo = lds_tr16(vp), hi = lds_tr16(vp + 16 * 72);
                    const bf16x8 av = {lo[0], lo[1], lo[2], lo[3], hi[0], hi[1], hi[2], hi[3]};
#pragma unroll
                    for (int mt = 0; mt < 2; ++mt) o[mt][nt] = MFMA16(av, pb[mt][ks], o[mt][nt]); }
        }
    };
    u32x4 kregA = *(const u32x4*)&Kb[(kvrow0 + 64 * kc0 + lrow) * (long)ldkv + 8 * lcv], vregA = *(const u32x4*)&Vb[(kvrow0 + 64 * kc0 + lrow) * (long)ldkv + 8 * lcv];
    u32x4 kregB = kregA, vregB = vregA;
    if (kc0 + 1 < kc1) { kregB = *(const u32x4*)&Kb[(kvrow0 + 64 * (kc0 + 1) + lrow) * (long)ldkv + 8 * lcv]; vregB = *(const u32x4*)&Vb[(kvrow0 + 64 * (kc0 + 1) + lrow) * (long)ldkv + 8 * lcv]; }
#define ATT_STEP(KREG, VREG, BUF) { \
        bf16* Ks = KS + (BUF) * 4608; bf16* Vs = VS + (BUF) * 4608; \
        *(u32x4*)&Ks[lrow * 72 + 8 * lcv] = KREG; *(u32x4*)&Vs[lrow * 72 + 8 * lcv] = VREG; \
        __syncthreads(); \
        if (kc + 2 < kc1) { KREG = *(const u32x4*)&Kb[(kvrow0 + 64 * (kc + 2) + lrow) * (long)ldkv + 8 * lcv]; VREG = *(const u32x4*)&Vb[(kvrow0 + 64 * (kc + 2) + lrow) * (long)ldkv + 8 * lcv]; } \
        attn_step(Ks, Vs, kc); }
    for (int kc = kc0; kc < kc1; kc += 2) {
        ATT_STEP(kregA, vregA, 0)
        if (kc + 1 < kc1) { ++kc; ATT_STEP(kregB, vregB, 1) --kc; }
    }
#undef ATT_STEP
#pragma unroll
    for (int mt = 0; mt < 2; ++mt) { const float l = xadd32(xadd16(lrun[mt])); const float inv = 1.f / l;
        bf16* orow = Ow + (size_t)(16 * mt + r) * ldo + 16 * (q & 1) + 8 * (q >> 1);
#pragma unroll
        for (int k = 0; k < 2; ++k) { u32x2 wa, wb; wa.x = pk2(o[mt][2 * k][0] * inv, o[mt][2 * k][1] * inv); wa.y = pk2(o[mt][2 * k][2] * inv, o[mt][2 * k][3] * inv);
            wb.x = pk2(o[mt][2 * k + 1][0] * inv, o[mt][2 * k + 1][1] * inv); wb.y = pk2(o[mt][2 * k + 1][2] * inv, o[mt][2 * k + 1][3] * inv);
            *(u32x4*)(orow + 32 * k) = pair16(wa, wb); } }
}

__device__ __forceinline__ void qk_conv8(const bf16* PA, int b, int tpos, int col, const float* cw, const float* cb, float* o8) {
    { const f32x4 b0 = *(const f32x4*)(cb + col), b1 = *(const f32x4*)(cb + col + 4); o8[0] = b0.x; o8[1] = b0.y; o8[2] = b0.z; o8[3] = b0.w; o8[4] = b1.x; o8[5] = b1.y; o8[6] = b1.z; o8[7] = b1.w; }
#pragma unroll
    for (int jj = 0; jj < 4; ++jj) { const int tt = tpos - 3 + jj;
        if (tt >= 0) { const u32x4 raw = *(const u32x4*)&PA[((size_t)b * SEQ + tt) * NPA + col]; float f[8]; unpack8(raw, f);
            const f32x4 w0 = *(const f32x4*)(cw + jj * 1536 + col), w1 = *(const f32x4*)(cw + jj * 1536 + col + 4);
            o8[0] += w0.x * f[0]; o8[1] += w0.y * f[1]; o8[2] += w0.z * f[2]; o8[3] += w0.w * f[3]; o8[4] += w1.x * f[4]; o8[5] += w1.y * f[5]; o8[6] += w1.z * f[6]; o8[7] += w1.w * f[7]; } }
#pragma unroll
    for (int e = 0; e < 8; ++e) o8[e] = siluf_(o8[e]);
}
__device__ __forceinline__ void qk_conv_rows4(const bf16* PA, int b, int tp0, int col, const float* cw, const float* cb, float scale, const float* rowscale, u32x4* outp) {
    u32x4 raw[7];
#pragma unroll
    for (int i = 0; i < 7; ++i) { const int tt = tp0 - 3 + i; raw[i] = (u32x4){0u, 0u, 0u, 0u}; if (tt >= 0) raw[i] = *(const u32x4*)&PA[((size_t)b * SEQ + tt) * NPA + col]; }
    float w[4][8], bb[8];
#pragma unroll
    for (int jj = 0; jj < 4; ++jj) { const f32x4 w0 = *(const f32x4*)(cw + jj * 1536 + col), w1 = *(const f32x4*)(cw + jj * 1536 + col + 4);
        w[jj][0] = w0.x; w[jj][1] = w0.y; w[jj][2] = w0.z; w[jj][3] = w0.w; w[jj][4] = w1.x; w[jj][5] = w1.y; w[jj][6] = w1.z; w[jj][7] = w1.w; }
    { const f32x4 b0 = *(const f32x4*)(cb + col), b1 = *(const f32x4*)(cb + col + 4); bb[0] = b0.x; bb[1] = b0.y; bb[2] = b0.z; bb[3] = b0.w; bb[4] = b1.x; bb[5] = b1.y; bb[6] = b1.z; bb[7] = b1.w; }
    float f[7][8];
#pragma unroll
    for (int i = 0; i < 7; ++i) unpack8(raw[i], f[i]);
#pragma unroll
    for (int rr = 0; rr < 4; ++rr) { float o8[8]; const float sc_ = rowscale ? scale * rowscale[rr] : scale;
#pragma unroll
        for (int e = 0; e < 8; ++e) { const float y = bb[e] + w[0][e] * f[rr][e] + w[1][e] * f[rr + 1][e] + w[2][e] * f[rr + 2][e] + w[3][e] * f[rr + 3][e]; o8[e] = siluf_(y) * sc_; }
        outp[rr] = pack8(o8); }
}
__device__ __forceinline__ void mlstm_local_unit(char* lds, int tid, int unit, const bf16* PA, const float* GT, const float* gate_b, const float* cw, const float* cb,
                                                 bf16* CS, float* DN, float* MLOC, float* BLAST) {
    const int lane = tid & 63, w = __builtin_amdgcn_readfirstlane(tid >> 6), r = lane & 15, q = lane >> 4;
    const int bh = unit >> 6, c = unit & 63, b = bh >> 2, h = bh & 3; const size_t t0 = (size_t)b * SEQ + 64 * c;
    bf16* Kn = (bf16*)lds; bf16* Vn = Kn + 64 * 200; float* ew = (float*)(lds + 2 * 25600);
    u32x4 vpre[3];
#pragma unroll
    for (int i = 0; i < 3; ++i) { const int idx = tid + 512 * i, s_ = idx / 24, dv = idx % 24; vpre[i] = *(const u32x4*)&PA[(t0 + s_) * NPA + PA_V + h * 192 + 8 * dv]; }
    __syncthreads();
    if (tid < 64) {
        const float ig = GT[(t0 + tid) * 8 + h] + gate_b[h], fg = GT[(t0 + tid) * 8 + 4 + h] + gate_b[4 + h];
        const float bc = wave_incl_sum(logsigmoidf_(fg), lane), bl = __shfl(bc, 63);
        const float wv = bl - bc + ig, ml = wave_max(wv);
        ew[tid] = __expf(wv - ml);
        if (tid == 0) { MLOC[unit] = ml; BLAST[unit] = bl; }
    }
#pragma unroll
    for (int i = 0; i < 3; ++i) { const int idx = tid + 512 * i, s_ = idx / 24, dv = idx % 24; *(u32x4*)&Vn[s_ * 200 + 8 * dv] = vpre[i]; }
    __syncthreads();
    if (tid < 384) { const int rg = tid / 24, dv = tid - 24 * rg; u32x4 o4[4];
        qk_conv_rows4(PA, b, 64 * c + 4 * rg, PA_K + h * 192 + 8 * dv, cw, cb, 0.07216878364870322f, ew + 4 * rg, o4);
#pragma unroll
        for (int rr = 0; rr < 4; ++rr) *(u32x4*)&Kn[(4 * rg + rr) * 200 + 8 * dv] = o4[rr]; }
    __syncthreads();
    {
        const int eg = w & 3, dg = w >> 2, qq = r >> 2, pp = r & 3;
        f32x4 acc[3][6];
#pragma unroll
        for (int i = 0; i < 3; ++i)
#pragma unroll
            for (int jn = 0; jn < 6; ++jn) acc[i][jn] = (f32x4){0.f, 0.f, 0.f, 0.f};
#pragma unroll
        for (int ks = 0; ks < 2; ++ks) { bf16x8 av[3];
#pragma unroll
            for (int i = 0; i < 3; ++i) { const bf16* vp = Vn + (32 * ks + 8 * q + qq) * 200 + 16 * (3 * eg + i) + 4 * pp; const v4i16_t lo = lds_tr16(vp), hi = lds_tr16(vp + 4 * 200);
                av[i] = (bf16x8){lo[0], lo[1], lo[2], lo[3], hi[0], hi[1], hi[2], hi[3]}; }
#pragma unroll
            for (int jn = 0; jn < 6; ++jn) { const bf16* kp = Kn + (32 * ks + 8 * q + qq) * 200 + 16 * (6 * dg + jn) + 4 * pp; const v4i16_t lo = lds_tr16(kp), hi = lds_tr16(kp + 4 * 200);
                const bf16x8 ak = {lo[0], lo[1], lo[2], lo[3], hi[0], hi[1], hi[2], hi[3]};
#pragma unroll
                for (int i = 0; i < 3; ++i) acc[i][jn] = MFMA16(ak, av[i], acc[i][jn]); } }
        bf16* cs = CS + (size_t)unit * 36864;
#pragma unroll
        for (int i = 0; i < 3; ++i)
#pragma unroll
            for (int jp = 0; jp < 3; ++jp) { u32x2 oa, ob; oa.x = pk2(acc[i][2 * jp][0], acc[i][2 * jp][1]); oa.y = pk2(acc[i][2 * jp][2], acc[i][2 * jp][3]);
                ob.x = pk2(acc[i][2 * jp + 1][0], acc[i][2 * jp + 1][1]); ob.y = pk2(acc[i][2 * jp + 1][2], acc[i][2 * jp + 1][3]);
                *(u32x4*)&cs[(16 * (3 * eg + i) + r) * 192 + 16 * (6 * dg + 2 * jp + (q & 1)) + 8 * (q >> 1)] = pair16(oa, ob); }
    }
    if (tid < 192) { float s0 = 0.f, s1 = 0.f;
#pragma unroll 8
        for (int k = 0; k < 64; k += 2) { s0 += bf2f(Kn[k * 200 + tid]); s1 += bf2f(Kn[(k + 1) * 200 + tid]); }
        DN[(size_t)unit * 192 + tid] = s0 + s1; }
}
__device__ __forceinline__ void mlstm_scan(int tid, bf16* CS, float* DN, const float* MLOC, const float* BLAST, float* MST) {
    const int gt = blockIdx.x * 512 + tid, NT = gridDim.x * 512;
    for (int it = gt; it < 32 * 4608 + 32 * 192; it += NT) {
        if (it < 32 * 4608) {
            const int bh = it / 4608; const size_t off = (size_t)(it % 4608) * 8; float m = 0.f; float carry[8];
#pragma unroll
            for (int e = 0; e < 8; ++e) carry[e] = 0.f;
            for (int cb = 0; cb < 8; ++cb) { u32x4 v[8];
#pragma unroll
                for (int k = 0; k < 8; ++k) v[k] = *(const u32x4*)&CS[(size_t)(bh * 64 + cb * 8 + k) * 36864 + off];
#pragma unroll
                for (int k = 0; k < 8; ++k) { const int unit = bh * 64 + cb * 8 + k; const float ml = MLOC[unit], bl = BLAST[unit];
                    const float mn = fmaxf(bl + m, ml), dec = __expf(bl + m - mn), sc = __expf(ml - mn); float f[8]; unpack8(v[k], f);
                    *(u32x4*)&CS[(size_t)unit * 36864 + off] = pack8(carry);
#pragma unroll
                    for (int e = 0; e < 8; ++e) carry[e] = dec * carry[e] + sc * f[e];
                    if (off == 0) MST[unit] = m;
                    m = mn; } }
        } else {
            const int j = it - 32 * 4608, bh = j / 192, d = j % 192; float m = 0.f, carry = 0.f;
            for (int c = 0; c < 64; ++c) { const int unit = bh * 64 + c; const float ml = MLOC[unit], bl = BLAST[unit];
                const float mn = fmaxf(bl + m, ml), dec = __expf(bl + m - mn), sc = __expf(ml - mn); const float val = DN[(size_t)unit * 192 + d];
                DN[(size_t)unit * 192 + d] = carry; carry = dec * carry + sc * val; m = mn; }
        }
    }
}
__device__ __forceinline__ void mlstm_scan256(int tid, bf16* CS, float* DN, const float* MLOC, const float* BLAST, float* MST) {
    const int bh = blockIdx.x >> 3, seg = blockIdx.x & 7; const size_t off8 = (size_t)seg * 4608 + 8 * tid, off1 = (size_t)seg * 4608 + 4096 + tid;
    const bool has_n = tid < 24; const int nidx = blockIdx.x * 24 + tid, nbh = nidx / 192, nd = nidx % 192;
    float m = 0.f, mN = 0.f, carry[8], c1 = 0.f, cn = 0.f;
#pragma unroll
    for (int e = 0; e < 8; ++e) carry[e] = 0.f;
    for (int cb = 0; cb < 8; ++cb) { u32x4 v[8]; bf16 e1[8]; float dn[8];
#pragma unroll
        for (int k = 0; k < 8; ++k) { const size_t ub = (size_t)(bh * 64 + cb * 8 + k) * 36864; v[k] = *(const u32x4*)&CS[ub + off8]; e1[k] = CS[ub + off1];
            dn[k] = has_n ? DN[(size_t)(nbh * 64 + cb * 8 + k) * 192 + nd] : 0.f; }
#pragma unroll
        for (int k = 0; k < 8; ++k) { const int unit = bh * 64 + cb * 8 + k; const float ml = MLOC[unit], bl = BLAST[unit];
            const float mn = fmaxf(bl + m, ml), dec = __expf(bl + m - mn), sc = __expf(ml - mn); float f[8]; unpack8(v[k], f);
            const size_t ub = (size_t)unit * 36864;
            *(u32x4*)&CS[ub + off8] = pack8(carry); CS[ub + off1] = f2bf(c1);
#pragma unroll
            for (int e = 0; e < 8; ++e) carry[e] = dec * carry[e] + sc * f[e];
            c1 = dec * c1 + sc * bf2f(e1[k]);
            if (seg == 0 && tid == 0) MST[unit] = m;
            m = mn;
            if (has_n) { const int un = nbh * 64 + cb * 8 + k; const float ml2 = MLOC[un], bl2 = BLAST[un]; const float mn2 = fmaxf(bl2 + mN, ml2), dec2 = __expf(bl2 + mN - mn2), sc2 = __expf(ml2 - mn2);
                DN[(size_t)un * 192 + nd] = cn; cn = dec2 * cn + sc2 * dn[k]; mN = mn2; } } }
}
__device__ __forceinline__ void mlstm_out_unit(char* lds, int tid, int unit, bf16* PA, const float* GT, const float* gate_b, const float* cw, const float* cb, const float* head_g,
                                               const bf16* CS, const float* NS, const float* MST, bf16* OB, int ldob) {
    const int lane = tid & 63, w = tid >> 6, r = lane & 15, q = lane >> 4;
    const int bh = unit >> 6, c = unit & 63, b = bh >> 2, h = bh & 3; const size_t t0 = (size_t)b * SEQ + 64 * c;
    bf16* Qs = (bf16*)lds; bf16* Ks = Qs + 64 * 200; bf16* Vt = Ks + 64 * 200; bf16* Sp = Vt + 192 * 72; float* sc = (float*)(Sp + 64 * 72);
    float* at = sc; float* gs = sc + 64; float* inter = sc + 128; float* emn = sc + 192; float* rden = sc + 256; float* nst = sc + 320;
    float* Hs = (float*)lds;
    __syncthreads();
    if (tid < 64) {
        const float ig = GT[(t0 + tid) * 8 + h] + gate_b[h], fg = GT[(t0 + tid) * 8 + 4 + h] + gate_b[4 + h];
        const float bc = wave_incl_sum(logsigmoidf_(fg), lane), g = ig - bc, pm = wave_incl_max(g, lane);
        const float mst = MST[unit], mt = bc + fmaxf(mst, pm);
        at[tid] = bc - mt; gs[tid] = g; inter[tid] = __expf(bc + mst - mt); emn[tid] = __expf(-mt);
    } else if (tid < 256) nst[tid - 64] = NS[(size_t)unit * 192 + tid - 64];
#pragma unroll
    for (int i = 0; i < 3; ++i) { const int idx = tid + 512 * i, s_ = idx / 24, dv = idx % 24; float v8[8];
        qk_conv8(PA, b, 64 * c + s_, h * 192 + 8 * dv, cw, cb, v8); *(u32x4*)&Qs[s_ * 200 + 8 * dv] = pack8(v8);
        qk_conv8(PA, b, 64 * c + s_, PA_K + h * 192 + 8 * dv, cw, cb, v8);
#pragma unroll
        for (int e = 0; e < 8; ++e) v8[e] *= 0.07216878364870322f;
        *(u32x4*)&Ks[s_ * 200 + 8 * dv] = pack8(v8); }
#pragma unroll
    for (int i = 0; i < 3; ++i) { const int idx = tid + 512 * i, s_ = idx & 63, dv = idx >> 6;
        const u32x4 v = *(const u32x4*)&PA[(t0 + s_) * NPA + PA_V + h * 192 + 8 * dv]; bf16* dvp = Vt + (8 * dv) * 72 + s_;
        dvp[0] = (bf16)(v.x & 0xffffu); dvp[72] = (bf16)(v.x >> 16); dvp[144] = (bf16)(v.y & 0xffffu); dvp[216] = (bf16)(v.y >> 16);
        dvp[288] = (bf16)(v.z & 0xffffu); dvp[360] = (bf16)(v.z >> 16); dvp[432] = (bf16)(v.w & 0xffffu); dvp[504] = (bf16)(v.w >> 16); }
    __syncthreads();
    {
        const int mt_ = w >> 1; f32x4 sa[2] = {(f32x4){0.f, 0.f, 0.f, 0.f}, (f32x4){0.f, 0.f, 0.f, 0.f}};
#pragma unroll
        for (int ks = 0; ks < 6; ++ks) { const bf16x8 a = *(const bf16x8*)&Qs[(16 * mt_ + r) * 200 + 32 * ks + 8 * q];
#pragma unroll
            for (int n2 = 0; n2 < 2; ++n2) { const int nt = (w & 1) * 2 + n2; const bf16x8 bk = *(const bf16x8*)&Ks[(16 * nt + r) * 200 + 32 * ks + 8 * q]; sa[n2] = MFMA16(a, bk, sa[n2]); } }
#pragma unroll
        for (int n2 = 0; n2 < 2; ++n2)
#pragma unroll
            for (int jj = 0; jj < 4; ++jj) { const int t = 16 * mt_ + 4 * q + jj, s_ = 16 * ((w & 1) * 2 + n2) + r;
                const float v = (s_ <= t) ? sa[n2][jj] * __expf(at[t] + gs[s_]) : 0.f; Sp[t * 72 + s_] = f2bf(v); }
    }
    __syncthreads();
    {
        const int t = tid >> 3, part = tid & 7; float a = 0.f, qn = 0.f;
#pragma unroll
        for (int k = 0; k < 8; ++k) a += bf2f(Sp[t * 72 + part * 8 + k]);
#pragma unroll
        for (int k = 0; k < 24; ++k) qn += bf2f(Qs[t * 200 + part * 24 + k]) * nst[part * 24 + k];
        a += inter[t] * qn; a += __shfl_xor(a, 1); a += __shfl_xor(a, 2); a += __shfl_xor(a, 4);
        if (part == 0) rden[t] = 1.f / fmaxf(fabsf(a), emn[t]);
    }
    {
        const int mt_ = w & 3, eg = w >> 2; f32x4 acc[6];
#pragma unroll
        for (int i = 0; i < 6; ++i) acc[i] = (f32x4){0.f, 0.f, 0.f, 0.f};
        const bf16* cs = CS + (size_t)unit * 36864;
#pragma unroll
        for (int ks = 0; ks < 6; ++ks) { const bf16x8 a = *(const bf16x8*)&Qs[(16 * mt_ + r) * 200 + 32 * ks + 8 * q];
#pragma unroll
            for (int i = 0; i < 6; ++i) { const bf16x8 bc_ = *(const bf16x8*)&cs[(16 * (6 * eg + i) + r) * 192 + 32 * ks + 8 * q]; acc[i] = MFMA16(a, bc_, acc[i]); } }
#pragma unroll
        for (int jj = 0; jj < 4; ++jj) { const float it_ = inter[16 * mt_ + 4 * q + jj];
#pragma unroll
            for (int i = 0; i < 6; ++i) acc[i][jj] *= it_; }
#pragma unroll
        for (int ks = 0; ks < 2; ++ks) { const bf16x8 a = *(const bf16x8*)&Sp[(16 * mt_ + r) * 72 + 32 * ks + 8 * q];
#pragma unroll
            for (int i = 0; i < 6; ++i) { const bf16x8 bv = *(const bf16x8*)&Vt[(16 * (6 * eg + i) + r) * 72 + 32 * ks + 8 * q]; acc[i] = MFMA16(a, bv, acc[i]); } }
        __syncthreads();
#pragma unroll
        for (int jj = 0; jj < 4; ++jj) { const int t = 16 * mt_ + 4 * q + jj; const float rd = rden[t];
#pragma unroll
            for (int i = 0; i < 6; ++i) Hs[t * 196 + 16 * (6 * eg + i) + r] = acc[i][jj] * rd; }
    }
    __syncthreads();
    {
        const int t = tid >> 3, part = tid & 7; float hv[24]; float ss = 0.f;
#pragma unroll
        for (int k = 0; k < 6; ++k) { const f32x4 x = *(const f32x4*)&Hs[t * 196 + part * 24 + 4 * k]; hv[4 * k] = x.x; hv[4 * k + 1] = x.y; hv[4 * k + 2] = x.z; hv[4 * k + 3] = x.w;
            ss += (x.x * x.x + x.y * x.y) + (x.z * x.z + x.w * x.w); }
        ss += __shfl_xor(ss, 1); ss += __shfl_xor(ss, 2); ss += __shfl_xor(ss, 4);
        const float rn = rsqrtf(ss * (1.f / 192.f) + 1e-6f);
        const bf16* op = PA + (t0 + t) * NPA + PA_O + h * 192 + part * 24; const float* hg = head_g + h * 192 + part * 24; bf16* mp = OB + (t0 + t) * ldob + h * 192 + part * 24;
#pragma unroll
        for (int k = 0; k < 3; ++k) { const u32x4 ov = *(const u32x4*)(op + 8 * k); float of[8]; unpack8(ov, of); float res[8];
#pragma unroll
            for (int e = 0; e < 8; ++e) res[e] = hv[8 * k + e] * rn * hg[8 * k + e] / (1.f + __expf(-of[e]));
            *(u32x4*)(mp + 8 * k) = pack8(res); }
    }
}
__device__ __forceinline__ void mlstm_out_pair(char* lds, int tid, int pair, bf16* PA, const float* GT, const float* gate_b, const float* cw, const float* cb, const float* head_g,
                                               const bf16* CS, const float* NS, const float* MST, bf16* OB, int ldob) {
    const int hf = tid >> 8, th = tid & 255, lane = tid & 63, wh = __builtin_amdgcn_readfirstlane(th >> 6), r = lane & 15, q = lane >> 4;
    const int unit = 2 * pair + hf;
    const int bh = unit >> 6, c = unit & 63, b = bh >> 2, h = bh & 3; const size_t t0 = (size_t)b * SEQ + 64 * c;
    char* base = lds + hf * 65536;
    bf16* Qs = (bf16*)base; bf16* Ks = Qs + 64 * 200; bf16* Vs = Ks; bf16* Sp = Ks + 64 * 200; float* sc = (float*)(Sp + 64 * 72);
    float* at = sc; float* gs = sc + 64; float* inter = sc + 128; float* emn = sc + 192; float* rden = sc + 256; float* nst = sc + 320;
    float* Hs = (float*)base;
    __syncthreads();
    if (th < 64) {
        const float ig = GT[(t0 + th) * 8 + h] + gate_b[h], fg = GT[(t0 + th) * 8 + 4 + h] + gate_b[4 + h];
        const float bc = wave_incl_sum(logsigmoidf_(fg), lane), g = ig - bc, pm = wave_incl_max(g, lane);
        const float mst = MST[unit], mt = bc + fmaxf(mst, pm);
        at[th] = bc - mt; gs[th] = g; inter[th] = __expf(bc + mst - mt); emn[th] = __expf(-mt);
    } else nst[th - 64] = NS[(size_t)unit * 192 + th - 64];
#pragma unroll 1
    for (int i = 0; i < 3; ++i) { const int task = th + 256 * i, ten = task / 384, rem = task - 384 * ten, rg = rem / 24, dv = rem - 24 * rg;
        u32x4 o4[4]; qk_conv_rows4(PA, b, 64 * c + 4 * rg, ten * PA_K + h * 192 + 8 * dv, cw, cb, ten ? 0.07216878364870322f : 1.f, nullptr, o4);
        bf16* dst = (ten ? Ks : Qs) + (4 * rg) * 200 + 8 * dv;
#pragma unroll
        for (int rr = 0; rr < 4; ++rr) *(u32x4*)&dst[rr * 200] = o4[rr]; }
    __syncthreads();
    bf16x8 bcf[6][3];
    {   const bf16* cs = CS + (size_t)unit * 36864;
#pragma unroll
        for (int ks = 0; ks < 6; ++ks)
#pragma unroll
            for (int i = 0; i < 3; ++i) bcf[ks][i] = *(const bf16x8*)&cs[(16 * (3 * wh + i) + r) * 192 + 32 * ks + 8 * q]; }
    {
        f32x4 sa[4];
#pragma unroll
        for (int nt = 0; nt < 4; ++nt) sa[nt] = (f32x4){0.f, 0.f, 0.f, 0.f};
#pragma unroll
        for (int ks = 0; ks < 6; ++ks) { const bf16x8 a = *(const bf16x8*)&Qs[(16 * wh + r) * 200 + 32 * ks + 8 * q];
#pragma unroll
            for (int nt = 0; nt < 4; ++nt) { const bf16x8 bk = *(const bf16x8*)&Ks[(16 * nt + r) * 200 + 32 * ks + 8 * q]; sa[nt] = MFMA16(a, bk, sa[nt]); } }
#pragma unroll
        for (int nt = 0; nt < 4; ++nt)
#pragma unroll
            for (int jj = 0; jj < 4; ++jj) { const int t = 16 * wh + 4 * q + jj, s_ = 16 * nt + r;
                const float v = (s_ <= t) ? sa[nt][jj] * __expf(at[t] + gs[s_]) : 0.f; Sp[t * 72 + s_] = f2bf(v); }
    }
    __syncthreads();
#pragma unroll
    for (int i = 0; i < 6; ++i) { const int idx = th + 256 * i, s_ = idx / 24, dv = idx % 24; *(u32x4*)&Vs[s_ * 200 + 8 * dv] = *(const u32x4*)&PA[(t0 + s_) * NPA + PA_V + h * 192 + 8 * dv]; }
    {
        const int t = th >> 2, part = th & 3; float a = 0.f, qn = 0.f;
#pragma unroll
        for (int k = 0; k < 2; ++k) { float f8[8]; unpack8(*(const u32x4*)&Sp[t * 72 + part * 16 + 8 * k], f8); a += ((f8[0] + f8[1]) + (f8[2] + f8[3])) + ((f8[4] + f8[5]) + (f8[6] + f8[7])); }
#pragma unroll
        for (int k = 0; k < 6; ++k) { float f8[8]; unpack8(*(const u32x4*)&Qs[t * 200 + part * 48 + 8 * k], f8); const f32x4 n0 = *(const f32x4*)&nst[part * 48 + 8 * k], n1 = *(const f32x4*)&nst[part * 48 + 8 * k + 4];
            qn += ((f8[0] * n0.x + f8[1] * n0.y) + (f8[2] * n0.z + f8[3] * n0.w)) + ((f8[4] * n1.x + f8[5] * n1.y) + (f8[6] * n1.z + f8[7] * n1.w)); }
        a += inter[t] * qn; a += __shfl_xor(a, 1); a += __shfl_xor(a, 2);
        if (part == 0) rden[t] = 1.f / fmaxf(fabsf(a), emn[t]);
    }
    f32x4 acc[4][3];
#pragma unroll
    for (int mt = 0; mt < 4; ++mt)
#pragma unroll
        for (int i = 0; i < 3; ++i) acc[mt][i] = (f32x4){0.f, 0.f, 0.f, 0.f};
    {
#pragma unroll
        for (int ks = 0; ks < 6; ++ks) {
#pragma unroll
            for (int mt = 0; mt < 4; ++mt) { const bf16x8 a = *(const bf16x8*)&Qs[(16 * mt + r) * 200 + 32 * ks + 8 * q];
#pragma unroll
                for (int i = 0; i < 3; ++i) acc[mt][i] = MFMA16(a, bcf[ks][i], acc[mt][i]); } }
#pragma unroll
        for (int mt = 0; mt < 4; ++mt)
#pragma unroll
            for (int jj = 0; jj < 4; ++jj) { const float it_ = inter[16 * mt + 4 * q + jj];
#pragma unroll
                for (int i = 0; i < 3; ++i) acc[mt][i][jj] *= it_; }
    }
    __syncthreads();
    {   const int qq = r >> 2, pp = r & 3;
#pragma unroll
        for (int ks = 0; ks < 2; ++ks) { bf16x8 bv[3];
#pragma unroll
            for (int i = 0; i < 3; ++i) { const bf16* vp = Vs + (32 * ks + 8 * q + qq) * 200 + 16 * (3 * wh + i) + 4 * pp; const v4i16_t lo = lds_tr16(vp), hi = lds_tr16(vp + 4 * 200);
                bv[i] = (bf16x8){lo[0], lo[1], lo[2], lo[3], hi[0], hi[1], hi[2], hi[3]}; }
#pragma unroll
            for (int mt = 0; mt < 4; ++mt) { const bf16x8 a = *(const bf16x8*)&Sp[(16 * mt + r) * 72 + 32 * ks + 8 * q];
#pragma unroll
                for (int i = 0; i < 3; ++i) acc[mt][i] = MFMA16(a, bv[i], acc[mt][i]); } }
    }
    __syncthreads();
#pragma unroll
    for (int mt = 0; mt < 4; ++mt)
#pragma unroll
        for (int jj = 0; jj < 4; ++jj) { const int t = 16 * mt + 4 * q + jj; const float rd = rden[t];
#pragma unroll
            for (int i = 0; i < 3; ++i) Hs[t * 196 + 16 * (3 * wh + i) + r] = acc[mt][i][jj] * rd; }
    __syncthreads();
    {
        const int t = th >> 2, part = th & 3; float ss = 0.f;
#pragma unroll
        for (int k = 0; k < 12; ++k) { const f32x4 x = *(const f32x4*)&Hs[t * 196 + part * 48 + 4 * k]; ss += (x.x * x.x + x.y * x.y) + (x.z * x.z + x.w * x.w); }
        ss += __shfl_xor(ss, 1); ss += __shfl_xor(ss, 2);
        const float rn = rsqrtf(ss * (1.f / 192.f) + 1e-6f);
        const bf16* op = PA + (t0 + t) * NPA + PA_O + h * 192 + part * 48; const float* hg = head_g + h * 192 + part * 48; bf16* mp = OB + (t0 + t) * ldob + h * 192 + part * 48;
#pragma unroll
        for (int k = 0; k < 6; ++k) { const u32x4 ov = *(const u32x4*)(op + 8 * k); float of[8]; unpack8(ov, of); float res[8];
            const f32x4 x0 = *(const f32x4*)&Hs[t * 196 + part * 48 + 8 * k], x1 = *(const f32x4*)&Hs[t * 196 + part * 48 + 8 * k + 4];
            const float hv[8] = {x0.x, x0.y, x0.z, x0.w, x1.x, x1.y, x1.z, x1.w};
            const f32x4 h0 = *(const f32x4*)(hg + 8 * k), h1 = *(const f32x4*)(hg + 8 * k + 4); const float hgv[8] = {h0.x, h0.y, h0.z, h0.w, h1.x, h1.y, h1.z, h1.w};
#pragma unroll
            for (int e = 0; e < 8; ++e) res[e] = hv[e] * rn * hgv[e] * __builtin_amdgcn_rcpf(1.f + __expf(-of[e]));
            *(u32x4*)(mp + 8 * k) = pack8(res); }
    }
}
__device__ __forceinline__ void ffn_fix(int tid, bf16* ACT, const bf16* SIDE, const float* cw, const float* cb) {
    const int gt = blockIdx.x * 512 + tid, NT = gridDim.x * 512;
    for (int it = gt; it < 512 * 352; it += NT) { const int blk = it / 352, cv = it % 352, c0 = 8 * cv; const bf16* sd = SIDE + (size_t)blk * (6 * DFF) + c0;
        float gm2[8], gm1[8], g0[8], g1[8], u0[8], u1[8], r0[8], r1[8];
        if ((blk & 63) == 0) {
#pragma unroll
            for (int e = 0; e < 8; ++e) { gm2[e] = 0.f; gm1[e] = 0.f; }
        } else { unpack8(*(const u32x4*)(sd - 6 * DFF), gm2); unpack8(*(const u32x4*)(sd - 5 * DFF), gm1); }
        unpack8(*(const u32x4*)(sd + 2 * DFF), g0); unpack8(*(const u32x4*)(sd + 3 * DFF), g1); unpack8(*(const u32x4*)(sd + 4 * DFF), u0); unpack8(*(const u32x4*)(sd + 5 * DFF), u1);
#pragma unroll
        for (int e = 0; e < 8; ++e) { const float w0 = cw[c0 + e], w1 = cw[DFF + c0 + e], w2 = cw[2 * DFF + c0 + e], bb = cb[c0 + e];
            const float y0 = w0 * gm2[e] + w1 * gm1[e] + w2 * g0[e] + bb, y1 = w0 * gm1[e] + w1 * g0[e] + w2 * g1[e] + bb; r0[e] = siluf_(y0) * u0[e]; r1[e] = siluf_(y1) * u1[e]; }
        *(u32x4*)&ACT[(size_t)(64 * blk) * DFF + c0] = pack8(r0); *(u32x4*)&ACT[(size_t)(64 * blk + 1) * DFF + c0] = pack8(r1); }
}

#define XB_TMO      128
#define XB_XCNT(j)  (256  + 64 * (j))
#define XB_XSUB(j)  (1280 + 64 * (j))
#define XB_XGEN(j)  (2304 + 64 * (j))
#define XB_TOP      3328
#define XB_TOPGEN   3392
#define XCD_BAR_WORDS 3456
#define XB_SPIN_CAP (1u << 18)

__device__ __forceinline__ unsigned xb_ld(unsigned* p)              { return __hip_atomic_load(p, __ATOMIC_RELAXED, __HIP_MEMORY_SCOPE_AGENT); }
__device__ __forceinline__ unsigned xb_add(unsigned* p, unsigned v) { return __hip_atomic_fetch_add(p, v, __ATOMIC_RELAXED, __HIP_MEMORY_SCOPE_AGENT); }
__device__ __forceinline__ unsigned xb_xcc_id() { return (unsigned)__builtin_amdgcn_s_getreg((3 << 11) | 20) & 0xFu; }
#define XB_SPIN(cond, bar) do { unsigned _sp = 0; while (cond) { __builtin_amdgcn_s_sleep(1); \
    if ((++_sp & 255u) == 0u) { if (xb_ld(&(bar)[XB_TMO])) break; if (_sp > XB_SPIN_CAP) { atomicAdd(&(bar)[XB_TMO], 1u); break; } } } } while (0)

struct XcdBarrier {
    unsigned* bar; unsigned x;
    volatile LAS unsigned* st;
};

__device__ __forceinline__ XcdBarrier xcd_barrier_post(unsigned* bar, volatile LAS unsigned* st) {
    XcdBarrier b; b.bar = bar; b.x = xb_xcc_id(); b.st = st;
    if (threadIdx.x == 0) (void)xb_add(&bar[XB_XCNT(b.x)], 1u);
    return b;
}
__device__ __forceinline__ void xcd_barrier_complete(unsigned* bar, unsigned x, unsigned& nloc, unsigned& nx) {
    const unsigned G = gridDim.x * gridDim.y * gridDim.z;
    unsigned sum, cnt, mine, sp = 0u;
    for (;;) {
        sum = 0u; cnt = 0u; mine = 0u;
#pragma unroll
        for (unsigned j = 0; j < 16; ++j) { const unsigned c = xb_ld(&bar[XB_XCNT(j)]); sum += c; cnt += (c > 0u) ? 1u : 0u; mine = (j == x) ? c : mine; }
        if (sum == G) break;
        __builtin_amdgcn_s_sleep(1);
        if ((++sp & 255u) == 0u) { if (xb_ld(&bar[XB_TMO])) break; if (sp > XB_SPIN_CAP) { atomicAdd(&bar[XB_TMO], 1u); break; } }
    }
    nloc = mine > 0u ? mine : 1u; nx = cnt > 0u ? cnt : 1u;
}

__device__ __forceinline__ void xcd_barrier(const XcdBarrier& b) {
    asm volatile("s_waitcnt vmcnt(0)" ::: "memory");
    __syncthreads();
    if (threadIdx.x == 0) {
        unsigned* bar = b.bar;
        __builtin_amdgcn_s_waitcnt(0);
        unsigned nloc = b.st[0], nx = b.st[1];
        if (nloc == 0u) { xcd_barrier_complete(bar, b.x, nloc, nx); b.st[0] = nloc; b.st[1] = nx; }
        const unsigned old = xb_add(&bar[XB_XSUB(b.x)], 1u);
        const unsigned gen = old / nloc;
        if (old + 1u == (gen + 1u) * nloc) {
            __builtin_amdgcn_fence(__ATOMIC_RELEASE, "agent");
            asm volatile("s_waitcnt vmcnt(0)" ::: "memory");
            const unsigned og = xb_add(&bar[XB_TOP], 1u);
            const unsigned tg = og / nx;
            if (og + 1u == (tg + 1u) * nx) xb_add(&bar[XB_TOPGEN], 1u);
            else XB_SPIN(xb_ld(&bar[XB_TOPGEN]) == tg, bar);
            __builtin_amdgcn_fence(__ATOMIC_ACQUIRE, "agent");
            xb_add(&bar[XB_XGEN(b.x)], 1u);
            asm volatile("s_waitcnt vmcnt(0)" ::: "memory");
        } else {
            XB_SPIN(xb_ld(&bar[XB_XGEN(b.x)]) == gen, bar);
            __builtin_amdgcn_fence(__ATOMIC_ACQUIRE, "agent");
            asm volatile("s_waitcnt vmcnt(0)" ::: "memory");
        }
    }
    __syncthreads();
}

struct Args { const float* in[21]; float* out; unsigned char* ws; int ph_lo, ph_hi, coop, pad; };

template <class Epi, bool SP2 = MK_SP2> __device__ __forceinline__ void run_gemm(unsigned char* lds, const bf16* A, int lda, const bf16* Bt, int M, int N, int K, const Epi& E, int crot = 0) {
    pg8::Gemm g{A, Bt, M, N, K, lda}; pg8::StaticOrder S; S.init(M, N, (int)gridDim.x, (int)((blockIdx.x + crot) % gridDim.x));
    pg8::gemm_phase<Epi, pg8::StaticOrder, true, SP2>((PG8_LAS unsigned char*)lds, g, S, E);
}

__global__ void __launch_bounds__(512, 2) mk_fwd(Args args) {
    extern __shared__ __attribute__((aligned(16))) unsigned char lds[];
    cg::grid_group grid = cg::this_grid();
#define PHASE_IDS() int tid = threadIdx.x; asm volatile("" : "+v"(tid)); const int lane = tid & 63, wave = __builtin_amdgcn_readfirstlane(tid >> 6), gw = bid * 8 + wave; (void)lane; (void)gw
    const int G = gridDim.x, bid = blockIdx.x;
    unsigned char* ws = args.ws;
    const float* x = args.in[0]; const float* mem = args.in[1]; const float* norm_mix_g = args.in[2]; const float* norm_ffn_g = args.in[3];
    const float* a_w_in = args.in[4]; const float* a_gate_b = args.in[5]; const float* a_conv_w = args.in[6]; const float* a_conv_b = args.in[7];
    const float* a_head_g = args.in[8]; const float* a_w_out = args.in[9]; const float* kv_norm_g = args.in[10]; const float* w_kv = args.in[11];
    const float* b_w_in = args.in[12]; const float* b_rel = args.in[13]; const float* b_w_out = args.in[14]; const float* mem_w_kv = args.in[15];
    const float* ffn_w_up = args.in[16]; const float* ffn_conv_w = args.in[17]; const float* ffn_conv_b = args.in[18]; const float* ffn_w_down = args.in[19];
    const float* final_g = args.in[20];
    float* out = args.out;
    bf16* WAIN = (bf16*)(ws + WS_WAIN); bf16* WAOUT = (bf16*)(ws + WS_WAOUT); bf16* WB = (bf16*)(ws + WS_WB); bf16* WBOUT = (bf16*)(ws + WS_WBOUT); bf16* WM = (bf16*)(ws + WS_WM);

    bf16* MEMB = (bf16*)(ws + WS_MEMB); bf16* MKV = (bf16*)(ws + WS_MKV); float* DN = (float*)(ws + WS_DN);
    float* MLOC = (float*)(ws + WS_SC); float* BLAST = MLOC + 2048; float* MST = MLOC + 4096;
    bf16* XN = (bf16*)(ws + WS_XN); bf16* MIXB = (bf16*)(ws + WS_MIXB); float* SSQ = (float*)(ws + WS_SSQ); float* GATES = (float*)(ws + WS_GATES);
    bf16* PA = (bf16*)(ws + WS_PA); bf16* CS = (bf16*)(ws + WS_CS); bf16* U = (bf16*)(ws + WS_U); bf16* Gb = (bf16*)(ws + WS_G); bf16* PB = (bf16*)(ws + WS_PB);
    const int lo = args.ph_lo, hi = args.ph_hi; const bool coop = args.coop != 0;
    if (threadIdx.x < 64) ((LAS unsigned*)((LAS unsigned char*)lds + 131072))[threadIdx.x] = 0u;
    __syncthreads();
    XcdBarrier bar; bar.bar = (unsigned*)ws; bar.x = 0; bar.st = nullptr;
    if (coop) bar = xcd_barrier_post((unsigned*)ws, (volatile LAS unsigned*)((LAS unsigned char*)lds + 131072 + 32));
    if (args.coop == 2) grid.sync();
    const int NGW = G * 8;
#define IN(k) (lo <= (k) && (k) < hi)
#define REPS(k) ((k) == MK_REP ? MK_NREP : 1)
#define SEAM(k) do { if (coop && IN(k) && IN((k) + 1)) xcd_barrier(bar); } while (0)

    if (IN(0)) for (int rep_ = 0; rep_ < REPS(0); ++rep_) { PHASE_IDS();
        float* scr = (float*)(lds + wave * 16384);
        for (int it = gw; it < 12928; it += NGW) { int r = it;
            if (r < 1664) { tr_item(a_w_in, 1024, 3336, norm_mix_g, WAIN, 1, r, 104, scr, lane); continue; } r -= 1664;
            if (r < 512) { tr_item(a_w_out, 1024, 1024, nullptr, WAOUT, 0, r, 32, scr, lane); continue; } r -= 512;
            if (r < 512) { tr_item(b_w_in, 1024, 1024, norm_mix_g + 1024, WB, 0, r, 32, scr, lane); continue; } r -= 512;
            if (r < 768) { tr_item(w_kv, 1024, 1536, kv_norm_g, WB + (size_t)1024 * 1024, 0, r, 48, scr, lane); continue; } r -= 768;
            if (r < 512) { tr_item(b_w_out, 1024, 1024, nullptr, WBOUT, 0, r, 32, scr, lane); continue; } r -= 512;
            if (r < 256) { tr_item(mem_w_kv, 1024, 512, nullptr, WM, 0, r, 16, scr, lane); continue; } r -= 256;
            if (r < 256) { tr_item(mem_w_kv + (size_t)1024 * 512, 1024, 512, nullptr, WM + (size_t)512 * 1024, 0, r, 16, scr, lane); continue; } r -= 256;
            if (r < 2816) { tr_item(ffn_w_up, 1024, 5632, norm_ffn_g, (bf16*)(ws + WS_WUP0), 2, r, 176, scr, lane); continue; } r -= 2816;
            if (r < 2816) { tr_item(ffn_w_up + (size_t)1024 * 5632, 1024, 5632, norm_ffn_g + 1024, (bf16*)(ws + WS_WUP1), 2, r, 176, scr, lane); continue; } r -= 2816;
            if (r < 1408) { tr_item(ffn_w_down, 2816, 1024, nullptr, (bf16*)(ws + WS_WDN0), 0, r, 32, scr, lane); continue; } r -= 1408;
            tr_item(ffn_w_down + (size_t)2816 * 1024, 2816, 1024, nullptr, (bf16*)(ws + WS_WDN1), 0, r, 32, scr, lane);
        }
        __syncthreads();
        {   float* wg = (float*)lds;
            for (int e = tid; e < 8192; e += 512) { const int k = e >> 3, c = e & 7; wg[c * 1024 + k] = a_w_in[(size_t)k * 3336 + 3072 + c] * norm_mix_g[k]; }
            __syncthreads();
            for (int m = 2 * gw; m < MTOK; m += 2 * NGW) row2_gates(x + (size_t)m * DM, XN + (size_t)m * DM, GATES + (size_t)m * 8, wg, lane); }
        for (int m = gw; m < NB * 256; m += NGW) row_to_bf16<false>(mem + (size_t)m * DM, MEMB + (size_t)m * DM, lane);
    }
    SEAM(0);
    if (IN(1)) for (int rep_ = 0; rep_ < REPS(1); ++rep_) {
        { pg8::EpiBf16 E{MKV, 1024, 0, 0, nullptr}; run_gemm(lds, MEMB, 1024, WM, NB * 256, 1024, 1024, E, G / 2); }
        { pg8::EpiBf16 E{PA, NPA, 0, 0, nullptr}; run_gemm(lds, XN, 1024, WAIN, MTOK, 3328, 1024, E); }
    }
    SEAM(1);
    if (IN(2)) for (int rep_ = 0; rep_ < REPS(2); ++rep_) { PHASE_IDS();
        for (int u = bid; u < 2048; u += G) mlstm_local_unit((char*)lds, tid, u, PA, GATES, a_gate_b, a_conv_w, a_conv_b, CS, DN, MLOC, BLAST);
        for (int it = bid; it < 512; it += G) { const int h = it & 3, g = (it >> 2) & 15, b = it >> 6; const size_t tw = (size_t)b * SEQ + 256 * g + 32 * wave;
            attn256_item((char*)lds, tid, PA + tw * NPA + PA_QM + 64 * h, NPA, MKV + 64 * h, MKV + 256 + 64 * h, (long)b * 256, 1024, 0, 4, 0, 3, false, 0, 0, nullptr, rep_ == 0 ? PA + tw * NPA + PA_QM + 64 * h : (bf16*)out + tw * DM + 64 * h, rep_ == 0 ? NPA : DM); }
    }
    SEAM(2);
    if (IN(3)) { PHASE_IDS(); if (G == 256) mlstm_scan256(tid, CS, DN, MLOC, BLAST, MST); else mlstm_scan(tid, CS, DN, MLOC, BLAST, MST); }
    SEAM(3);
    if (IN(4)) for (int rep_ = 0; rep_ < REPS(4); ++rep_) { PHASE_IDS(); for (int u = bid; u < 1024; u += G) mlstm_out_pair((char*)lds, tid, u, PA, GATES, a_gate_b, a_conv_w, a_conv_b, a_head_g, CS, DN, MST, rep_ == 0 ? PA + PA_O : (bf16*)out, rep_ == 0 ? NPA : 1024); }
    SEAM(4);
    if (IN(5)) for (int rep_ = 0; rep_ < REPS(5); ++rep_) { pg8::EpiRes<true> E{x, XN, DM, SSQ}; run_gemm(lds, PA + PA_O, NPA, WAOUT, MTOK, DM, DM, E); }
    SEAM(5);
#pragma unroll 1
    for (int l = 0; l < 2; ++l) {
        const int pb = 6 + 8 * l;
        if (IN(pb + 1)) { pg8::EpiAct E{U, Gb, SSQ, ffn_conv_w + (size_t)l * 3 * DFF, ffn_conv_b + (size_t)l * DFF}; run_gemm<pg8::EpiAct, true>(lds, XN, 1024, (bf16*)(ws + WS_WUP0 + (size_t)l * (WS_WUP1 - WS_WUP0)), MTOK, 2 * DFF, DM, E); }
        SEAM(pb + 1);
        if (IN(pb + 2)) { PHASE_IDS(); ffn_fix(tid, U, Gb, ffn_conv_w + (size_t)l * 3 * DFF, ffn_conv_b + (size_t)l * DFF); }
        SEAM(pb + 2);
        if (IN(pb + 3)) { pg8::EpiRes<false> E{nullptr, XN, DM, SSQ}; run_gemm(lds, U, DFF, (bf16*)(ws + WS_WDN0 + (size_t)l * (WS_WDN1 - WS_WDN0)), MTOK, DM, DFF, E); }
        SEAM(pb + 3);
        if (l == 0) {
            if (IN(11)) for (int rep_ = 0; rep_ < REPS(11); ++rep_) { pg8::EpiBf16 E{PB, NPB, 0, 0, SSQ}; run_gemm(lds, XN, 1024, WB, MTOK, NPB, DM, E); }
            SEAM(11);
            if (IN(12)) for (int rep_ = 0; rep_ < REPS(12); ++rep_) { PHASE_IDS();
                for (int it = bid; it < 1536; it += G) { const int h = it % 12, g = (it / 12) & 15, b = it / 192, w = wave, cq = 4 * g + (w >> 1); const size_t tw = (size_t)b * SEQ + 256 * g + 32 * w;
                    attn256_item((char*)lds, tid, PB + tw * NPB + 64 * h, NPB, PB + PB_K + 64 * h, PB + PB_V + 64 * h, (long)b * SEQ, NPB, g >= 2 ? 4 * g - 8 : 0, 4 * g + 4,
                                 cq >= 8 ? cq - 8 : 0, cq, true, cq - 8, 32 * (w & 1), b_rel + h * 192, MIXB + tw * DM + 64 * h, DM); }
                for (int it = bid; it < 512; it += G) { const int h = it & 3, g = (it >> 2) & 15, b = it >> 6; const size_t tw = (size_t)b * SEQ + 256 * g + 32 * wave;
                    attn256_item((char*)lds, tid, PB + tw * NPB + PB_QM + 64 * h, NPB, MKV + 512 + 64 * h, MKV + 768 + 64 * h, (long)b * 256, 1024, 0, 4, 0, 3, false, 0, 0, nullptr, MIXB + tw * DM + 768 + 64 * h, DM); }
            }
            SEAM(12);
            if (IN(13)) { pg8::EpiRes<false> E{nullptr, XN, DM, SSQ}; run_gemm(lds, MIXB, 1024, WBOUT, MTOK, DM, DM, E); }
            SEAM(13);
        }
    }
    if (IN(18)) { PHASE_IDS(); for (int m = gw; m < MTOK; m += NGW) final_norm_row(XN + (size_t)m * DM, SSQ + (size_t)m * 16, out + (size_t)m * DM, final_g, lane); }
#undef IN
#undef SEAM
}

#ifndef MK_MULTI
#define MK_MULTI 0
#endif
extern "C" void kernel_launch(void* const* d_in, const int* in_sizes, int n_in, void* d_out, int out_size, void* d_ws, size_t ws_size, hipStream_t stream) {
    static int grid = 0;
    if (grid == 0) {
        if (n_in != 21 || out_size != MTOK * DM || ws_size < WS_END) { fprintf(stderr, "kernel_launch: unexpected shapes (n_in %d out %d ws %zu)\n", n_in, out_size, ws_size); grid = -1; return; }
        int dev = 0, cus = 0, per_cu = 0;
        (void)hipGetDevice(&dev); (void)hipDeviceGetAttribute(&cus, hipDeviceAttributeMultiprocessorCount, dev);
        if (hipFuncSetAttribute((const void*)mk_fwd, hipFuncAttributeMaxDynamicSharedMemorySize, LDS_BYTES) != hipSuccess) { fprintf(stderr, "kernel_launch: hipFuncSetAttribute failed\n"); grid = -1; return; }
        if (hipOccupancyMaxActiveBlocksPerMultiprocessor(&per_cu, (const void*)mk_fwd, 512, LDS_BYTES) != hipSuccess || per_cu < 1) { fprintf(stderr, "kernel_launch: occupancy query says %d\n", per_cu); per_cu = 1; }
        (void)hipGetLastError();
        grid = cus * 1;
    }
    if (grid < 0) return;
    Args a{};
    for (int i = 0; i < 21; ++i) a.in[i] = (const float*)d_in[i];
    a.out = (float*)d_out; a.ws = (unsigned char*)d_ws;
#if MK_MULTI
    for (int p = 0; p < NPHASE; ++p) { a.ph_lo = p; a.ph_hi = p + 1; a.coop = 0; hipLaunchKernelGGL(mk_fwd, dim3(grid), dim3(512), LDS_BYTES, stream, a); }
#else
    a.ph_lo = 0; a.ph_hi = NPHASE; a.coop = 1;
    if (hipMemsetAsync(d_ws, 0, 65536, stream) != hipSuccess) { fprintf(stderr, "kernel_launch: memset failed\n"); return; }
    void* kargs[] = {&a};
    hipError_t e = hipLaunchCooperativeKernel((const void*)mk_fwd, dim3(grid), dim3(512), kargs, LDS_BYTES, stream);
    if (e != hipSuccess) fprintf(stderr, "kernel_launch: cooperative launch failed: %s (grid %d)\n", hipGetErrorString(e), grid);
#endif
}
```
